# Optimizing an MI355X kernel written in HIP

```python
import functools
import jax, jax.numpy as jnp
from jax import lax
import numpy as np


D_MODEL = 1024
BATCH = 16
SEQ = 2048
DEPTH = 2

GRID_W = 64
CTX_LEN = 256
N_MIXERS = 2
N_MOD = 6
EPS = 1e-6
GLA_HEADS = 4
GLA_KEY_DIM = D_MODEL // 2
GLA_VAL_DIM = D_MODEL
GLA_HEAD_K = GLA_KEY_DIM // GLA_HEADS
GLA_HEAD_V = GLA_VAL_DIM // GLA_HEADS
GLA_GATE_RANK = 16
GLA_GATE_TAU = 16.0
GLA_CHUNK = 64
GLA_IN_DIM = 2 * GLA_KEY_DIM + 2 * GLA_VAL_DIM + 2 * GLA_GATE_RANK
SC_DIM = D_MODEL
CONV_WIDTH = 3
FFN_HIDDEN = 5 * D_MODEL // 2

kernel_name = 'hybrid_gla_shortconv_convffn_dit'


def rmsnorm(x, gain):
    x32 = x.astype(jnp.float32)
    y = x32 * lax.rsqrt(jnp.mean(x32 * x32, axis=-1, keepdims=True) + EPS)
    return y.astype(x.dtype) * gain


def modulate(x, gain, shift, scale):
    return rmsnorm(x, gain) * (1 + scale) + shift


def dwconv3(u, w, axis):
    n = u.shape[axis]
    pad = [(0, 0)] * u.ndim
    pad[axis] = (1, 1)
    up = jnp.pad(u, pad)
    out = lax.slice_in_dim(up, 0, n, axis=axis) * w[0]
    for tap in range(1, CONV_WIDTH):
        out = out + lax.slice_in_dim(up, tap, tap + n, axis=axis) * w[tap]
    return out


def conv_grid(u, w, rows, axis):
    b, t, ch = u.shape
    return dwconv3(u.reshape(b, rows, GRID_W, ch), w, axis).reshape(b, t, ch)


def conv_seq(u, w):
    return dwconv3(u, w, 1)


def heads(t, dh):
    return t.reshape(t.shape[0], t.shape[1], -1, dh)


def gla_log_decay(a_low, w_a2, b_a):
    z = (a_low @ w_a2 + b_a).astype(jnp.float32)
    return heads(jax.nn.log_sigmoid(z) / GLA_GATE_TAU, GLA_HEAD_K)


def gla_scan(q, k, v, log_a, s0):
    bsz, t, nh, _ = q.shape
    dv = v.shape[-1]
    n = t // GLA_CHUNK

    def to_chunks(a):
        return a.astype(jnp.float32).reshape(bsz, n, GLA_CHUNK, nh, a.shape[-1]).transpose(1, 0, 3, 2, 4)

    xs = tuple(to_chunks(a) for a in (q, k, v, log_a))
    mask = jnp.tril(jnp.ones((GLA_CHUNK, GLA_CHUNK), dtype=bool))

    def step(s, inp):
        qi, ki, vi, gi = inp
        bcum = jnp.cumsum(gi, axis=-2)
        b_last = bcum[..., -1:, :]
        q_s = qi * jnp.exp(bcum)
        k_s = ki * jnp.exp(-bcum)
        k_d = ki * jnp.exp(b_last - bcum)
        att = jnp.where(mask, jnp.einsum('bhik,bhjk->bhij', q_s, k_s), 0.0)
        o = jnp.einsum('bhik,bhkv->bhiv', q_s, s) + jnp.einsum('bhij,bhjv->bhiv', att, vi)
        s_new = jnp.exp(b_last[..., 0, :])[..., None] * s + jnp.einsum('bhjk,bhjv->bhkv', k_d, vi)
        return s_new, o

    s_fin, oc = lax.scan(step, s0.astype(jnp.float32), xs)
    o = oc.transpose(1, 0, 3, 2, 4).reshape(bsz, t, nh, dv)
    return o, s_fin


def gla_state(k, v, log_a):
    bcum = jnp.cumsum(log_a, axis=1)
    k_d = k.astype(jnp.float32) * jnp.exp(bcum[:, -1:] - bcum)
    return jnp.einsum('bthk,bthv->bhkv', k_d, v.astype(jnp.float32))


def gla_split_cols(p):
    kt, vt, r = GLA_KEY_DIM, GLA_VAL_DIM, GLA_GATE_RANK
    return jnp.split(p, [kt, 2 * kt, 2 * kt + vt, 2 * kt + 2 * vt, 2 * kt + 2 * vt + r], axis=-1)


def gla_mixer(h, w_in, w_a2, b_a, head_gain, w_out, s0_f, s0_b):
    q, k, v, g, a_f, a_b = gla_split_cols(h @ w_in)
    q = heads(q, GLA_HEAD_K) * (GLA_HEAD_K ** -0.5)
    k = heads(k, GLA_HEAD_K)
    v = heads(v, GLA_HEAD_V)
    la_f = gla_log_decay(a_f, w_a2[0], b_a[0])
    la_b = gla_log_decay(a_b, w_a2[1], b_a[1])
    o_f, s_f = gla_scan(q, k, v, la_f, s0_f)
    flip = functools.partial(jnp.flip, axis=1)
    o_b, s_b = gla_scan(flip(q), flip(k), flip(v), flip(la_b), s0_b)
    o = o_f + flip(o_b)
    o = o * lax.rsqrt(jnp.mean(o * o, axis=-1, keepdims=True) + EPS)
    o = (o.astype(h.dtype) * head_gain).reshape(h.shape[0], h.shape[1], GLA_VAL_DIM)
    return (o * jax.nn.silu(g)) @ w_out, s_f, s_b


def gla_context_states(h, w_in, w_a2, b_a):
    kt, vt = GLA_KEY_DIM, GLA_VAL_DIM
    k, v = jnp.split(h @ w_in[:, kt:2 * kt + vt], [kt], axis=-1)
    a_f, a_b = jnp.split(h @ w_in[:, 2 * kt + 2 * vt:], 2, axis=-1)
    k = heads(k, GLA_HEAD_K)
    v = heads(v, GLA_HEAD_V)
    s_f = gla_state(k, v, gla_log_decay(a_f, w_a2[0], b_a[0]))
    s_b = gla_state(jnp.flip(k, 1), jnp.flip(v, 1), jnp.flip(gla_log_decay(a_b, w_a2[1], b_a[1]), 1))
    return s_f, s_b


def short_conv_mixer(h, w_in, conv_w, w_out, conv_fn):
    bg, cg, v = jnp.split(h @ w_in, 3, axis=-1)
    return (bg * conv_fn(cg * v, conv_w)) @ w_out


def conv_ffn(h, w_up, conv_w, conv_b, w_down, conv_fn):
    u = conv_fn(h @ w_up, conv_w) + conv_b
    a, gt = jnp.split(u, 2, axis=-1)
    return (a * jax.nn.silu(gt)) @ w_down


def setup_inputs(seed: int = 0) -> dict:
    key = jax.random.key(seed)
    ks = jax.random.split(key, 24)
    n_a = (DEPTH + N_MIXERS - 1) // N_MIXERS
    n_b = DEPTH // N_MIXERS
    f32 = jnp.float32

    def nrm(k, shape, scale):
        return jax.random.normal(k, shape, f32) * scale

    return {
        'x': nrm(ks[0], (BATCH, SEQ, D_MODEL), 1.0),
        'c': nrm(ks[1], (BATCH, D_MODEL), 1.0),
        'ctx': nrm(ks[2], (BATCH, CTX_LEN, D_MODEL), 1.0),
        'c_ctx': nrm(ks[3], (D_MODEL,), 1.0),
        'ada_w': nrm(ks[4], (DEPTH, D_MODEL, N_MOD * D_MODEL), 0.5 * D_MODEL ** -0.5),
        'ada_b': nrm(ks[5], (DEPTH, N_MOD * D_MODEL), 0.02),
        'norm_mix': 1.0 + nrm(ks[6], (DEPTH, D_MODEL), 0.02),
        'norm_ffn': 1.0 + nrm(ks[7], (DEPTH, D_MODEL), 0.02),
        'gla_w_in': nrm(ks[8], (n_a, D_MODEL, GLA_IN_DIM), D_MODEL ** -0.5),
        'gla_w_a2': nrm(ks[9], (n_a, 2, GLA_GATE_RANK, GLA_KEY_DIM), GLA_GATE_RANK ** -0.5),
        'gla_b_a': nrm(ks[10], (n_a, 2, GLA_KEY_DIM), 0.1),
        'gla_head_norm': 1.0 + nrm(ks[11], (n_a, GLA_HEAD_V), 0.02),
        'gla_w_out': nrm(ks[12], (n_a, GLA_VAL_DIM, D_MODEL), GLA_VAL_DIM ** -0.5),
        'sc_w_in': nrm(ks[13], (n_b, D_MODEL, 3 * SC_DIM), D_MODEL ** -0.5),
        'sc_conv_w': nrm(ks[14], (n_b, CONV_WIDTH, SC_DIM), CONV_WIDTH ** -0.5),
        'sc_w_out': nrm(ks[15], (n_b, SC_DIM, D_MODEL), SC_DIM ** -0.5),
        'ffn_w_up': nrm(ks[16], (DEPTH, D_MODEL, 2 * FFN_HIDDEN), D_MODEL ** -0.5),
        'ffn_conv_w': nrm(ks[17], (DEPTH, CONV_WIDTH, 2 * FFN_HIDDEN), CONV_WIDTH ** -0.5),
        'ffn_conv_b': nrm(ks[18], (DEPTH, 2 * FFN_HIDDEN), 0.02),
        'ffn_w_down': nrm(ks[19], (DEPTH, FFN_HIDDEN, D_MODEL), FFN_HIDDEN ** -0.5),
        'final_norm': 1.0 + nrm(ks[20], (D_MODEL,), 0.02),
    }


def reference(x, c, ctx, c_ctx, ada_w, ada_b, norm_mix, norm_ffn, gla_w_in, gla_w_a2, gla_b_a,
              gla_head_norm, gla_w_out, sc_w_in, sc_conv_w, sc_w_out, ffn_w_up, ffn_conv_w,
              ffn_conv_b, ffn_w_down, final_norm):
    rows = x.shape[1] // GRID_W
    conv_lat_rows = functools.partial(conv_grid, rows=rows, axis=2)
    conv_lat_cols = functools.partial(conv_grid, rows=rows, axis=1)
    h, hc = x, ctx
    sc, scc = jax.nn.silu(c), jax.nn.silu(c_ctx)
    for i in range(DEPTH):
        mixer, j = i % N_MIXERS, i // N_MIXERS
        ctx_later = any(l % N_MIXERS == 0 for l in range(i + 1, DEPTH))
        m = [t[:, None, :] for t in jnp.split(sc @ ada_w[i] + ada_b[i], N_MOD, axis=-1)]
        need_ctx = (mixer == 0) or ctx_later
        if need_ctx:
            mc = jnp.split(scc @ ada_w[i] + ada_b[i], N_MOD, axis=-1)
            hnc = modulate(hc, norm_mix[i], mc[0], mc[1])
        hn = modulate(h, norm_mix[i], m[0], m[1])
        if mixer == 0:
            if ctx_later:
                zero = jnp.zeros((hc.shape[0], GLA_HEADS, GLA_HEAD_K, GLA_HEAD_V), jnp.float32)
                yc, s_f, s_b = gla_mixer(hnc, gla_w_in[j], gla_w_a2[j], gla_b_a[j], gla_head_norm[j],
                                         gla_w_out[j], zero, zero)
            else:
                s_f, s_b = gla_context_states(hnc, gla_w_in[j], gla_w_a2[j], gla_b_a[j])
            y, _, _ = gla_mixer(hn, gla_w_in[j], gla_w_a2[j], gla_b_a[j], gla_head_norm[j],
                                gla_w_out[j], s_f, s_b)
        else:
            y = short_conv_mixer(hn, sc_w_in[j], sc_conv_w[j], sc_w_out[j], conv_lat_rows)
            if ctx_later:
                yc = short_conv_mixer(hnc, sc_w_in[j], sc_conv_w[j], sc_w_out[j], conv_seq)
        h = h + m[2] * y
        h = h + m[5] * conv_ffn(modulate(h, norm_ffn[i], m[3], m[4]), ffn_w_up[i], ffn_conv_w[i],
                                ffn_conv_b[i], ffn_w_down[i], conv_lat_cols)
        if ctx_later:
            hc = hc + mc[2] * yc
            hc = hc + mc[5] * conv_ffn(modulate(hc, norm_ffn[i], mc[3], mc[4]), ffn_w_up[i],
                                       ffn_conv_w[i], ffn_conv_b[i], ffn_w_down[i], conv_seq)
    return rmsnorm(h, final_norm)
```

```cpp
#include <hip/hip_runtime.h>
#include <hip/hip_cooperative_groups.h>
#include <cstdio>
#include <cstdint>
namespace cg = cooperative_groups;
namespace pg8 {
#define PG8_LAS __attribute__((address_space(3)))
typedef unsigned short bf16_t;
typedef short bf16x8 __attribute__((ext_vector_type(8)));
typedef float f32x4 __attribute__((ext_vector_type(4)));
typedef unsigned u32x4 __attribute__((ext_vector_type(4)));
constexpr int BM = 256, BK = 64, HALF = 128, HTB = HALF * BK * 2  , STAGE_BYTES = 8 * HTB, NXCD = 8, WGM = 8;

__host__ __device__ __forceinline__ int lds_byte(int r, int c) { const int st = (r >> 4) * 2 + (c >> 5), rr = r & 15, cc = c & 31, ob = rr * 64 + cc * 2; return st * 1024 + (ob ^ (((ob >> 9) & 1) << 5)); }
__host__ __device__ __forceinline__ void stage_rc(int b, int& R, int& C) { const int st = b / 1024, sb = b % 1024, swz = sb ^ (((sb >> 9) & 1) << 5); R = (st >> 1) * 16 + swz / 64; C = (st & 1) * 32 + (swz % 64) / 2; }
__host__ __device__ __forceinline__ int perm32(int rho) { const int n = rho >> 4, i = rho & 15; return 8 * (i >> 2) + 4 * n + (i & 3); }

struct Unit { int pm, pn; };
struct Gemm { const bf16_t* A; const bf16_t* Bt; int M, N, K; };

struct StaticOrder {
    int nM, nN, nwg, G, c;
    __host__ __device__ void init(int M, int N, int G_, int c_) { nM = M / BM; nN = N / BM; nwg = nM * nN; G = G_; c = c_; }
    __host__ __device__ bool next(int i, Unit& u) const {
        const long L = (long)i * G + c; if (L >= nwg) return false;
        int wgid = (int)L; { const int q = nwg / NXCD, r = nwg % NXCD, xcd = wgid % NXCD, off = wgid / NXCD; wgid = (xcd < r ? xcd * (q + 1) : r * (q + 1) + (xcd - r) * q) + off; }
        const int nig = WGM * nN, gid = wgid / nig, fm = gid * WGM, gsz = (nM - fm) < WGM ? (nM - fm) : WGM;
        u.pm = fm + ((wgid % nig) % gsz); u.pn = (wgid % nig) / gsz; return true;
    }
    __device__ __forceinline__ void a_ready(const Unit&) const {}
    __device__ __forceinline__ void done(const Unit&) const {}
};


__device__ __forceinline__ unsigned cvt_pk_bf16(float lo, float hi) { unsigned r; asm volatile("v_cvt_pk_bf16_f32 %0, %1, %2" : "=v"(r) : "v"(lo), "v"(hi)); return r; }

struct EpiBf16 {
    static constexpr bool PERM = true, AFTER_DRAIN = false;
    bf16_t* O; int ldc;
    __device__ __forceinline__ void operator()(const f32x4 (&acc)[2][2][4][2], const Unit& u, int wr, int wc, int fr, int fq) const {
        const int row0 = u.pm * BM + wr * 64 + fr; const int col0 = u.pn * BM + wc * 32 + 8 * fq;
#pragma unroll
        for (int ai = 0; ai < 2; ++ai)
#pragma unroll
            for (int m = 0; m < 4; ++m) { bf16_t* rowp = O + (size_t)(row0 + ai * HALF + m * 16) * ldc + col0;
#pragma unroll
                for (int bj = 0; bj < 2; ++bj) { const f32x4 v0 = acc[ai][bj][m][0], v1 = acc[ai][bj][m][1];
                    u32x4 w; w.x = cvt_pk_bf16(v0[0], v0[1]); w.y = cvt_pk_bf16(v0[2], v0[3]); w.z = cvt_pk_bf16(v1[0], v1[1]); w.w = cvt_pk_bf16(v1[2], v1[3]);
                    *(u32x4*)(rowp + bj * HALF) = w; } }
    }
};
struct EpiProj {
    static constexpr bool PERM = true, AFTER_DRAIN = false;
    bf16_t* O; int ldc; float* alow; int pn_low;
    __device__ __forceinline__ void operator()(const f32x4 (&acc)[2][2][4][2], const Unit& u, int wr, int wc, int fr, int fq) const {
        const int row0 = u.pm * BM + wr * 64 + fr; const int col0 = u.pn * BM + wc * 32 + 8 * fq;
#pragma unroll
        for (int ai = 0; ai < 2; ++ai)
#pragma unroll
            for (int m = 0; m < 4; ++m) { bf16_t* rowp = O + (size_t)(row0 + ai * HALF + m * 16) * ldc + col0;
#pragma unroll
                for (int bj = 0; bj < 2; ++bj) { const f32x4 v0 = acc[ai][bj][m][0], v1 = acc[ai][bj][m][1];
                    u32x4 w; w.x = cvt_pk_bf16(v0[0], v0[1]); w.y = cvt_pk_bf16(v0[2], v0[3]); w.z = cvt_pk_bf16(v1[0], v1[1]); w.w = cvt_pk_bf16(v1[2], v1[3]);
                    *(u32x4*)(rowp + bj * HALF) = w; } }
        if (u.pn == pn_low && wc == 0) {
#pragma unroll
            for (int ai = 0; ai < 2; ++ai)
#pragma unroll
                for (int m = 0; m < 4; ++m) { float* ap = alow + (size_t)(row0 + ai * HALF + m * 16) * 32 + 8 * fq;
                    *(f32x4*)(ap) = acc[ai][0][m][0]; *(f32x4*)(ap + 4) = acc[ai][0][m][1]; }
        }
    }
};
struct EpiResid {
    static constexpr bool PERM = false, AFTER_DRAIN = false;
    const float* base; float* out; const float* gate; int gstride; int rows_per_b; int ldc;
    __device__ __forceinline__ void operator()(const f32x4 (&acc)[2][2][4][2], const Unit& u, int wr, int wc, int fr, int fq) const {
        const int row0 = u.pm * BM + wr * 64 + fr, col0 = u.pn * BM + wc * 32 + 4 * fq;
        const int b = (u.pm * BM) / rows_per_b;
        f32x4 gv[2][2];
#pragma unroll
        for (int bj = 0; bj < 2; ++bj)
#pragma unroll
            for (int n = 0; n < 2; ++n) gv[bj][n] = *(const f32x4*)(gate + (size_t)b * gstride + col0 + bj * HALF + n * 16);
#pragma unroll
        for (int ai = 0; ai < 2; ++ai)
#pragma unroll
            for (int m = 0; m < 4; ++m) { const size_t off = (size_t)(row0 + ai * HALF + m * 16) * ldc + col0;
#pragma unroll
                for (int bj = 0; bj < 2; ++bj)
#pragma unroll
                    for (int n = 0; n < 2; ++n) { const f32x4 bs = *(const f32x4*)(base + off + bj * HALF + n * 16);
                        *(f32x4*)(out + off + bj * HALF + n * 16) = bs + gv[bj][n] * acc[ai][bj][m][n]; } }
    }
};

template <class Epi, class Sched, bool ALIGN_EPI = false, bool SP2 = false>
__device__ __forceinline__ void gemm_phase(PG8_LAS unsigned char* lds, const Gemm g, const Sched& S, const Epi& E) {
    const int tid = threadIdx.x, wid = __builtin_amdgcn_readfirstlane(tid >> 6), lane = tid & 63, wr = wid >> 2, wc = wid & 3, fr = lane & 15, fq = lane >> 4;
    const int K = g.K, nt = K / BK;
    unsigned voffA[2], voffB[2];
#pragma unroll
    for (int i = 0; i < 2; ++i) { int R, C; stage_rc(tid * 16 + i * 8192, R, C); const int Rb = Epi::PERM ? ((R & ~31) + perm32(R & 31)) : R;
        voffA[i] = (unsigned)(R * K + C) * 2u; voffB[i] = (unsigned)(Rb * K + C) * 2u; }
    const size_t kstep = (size_t)(BK * 2);
    const size_t hstep = (size_t)HALF * K * 2;
    const size_t tstep = 2 * hstep;
    const unsigned ldsw = (unsigned)wid * 1024u;
    const int aoff = lds_byte(wr * 64 + fr, fq * 8), boff = lds_byte(wc * 32 + fr, fq * 8);
#define PG8_SA(b, h) (((b) * 2 + (h)) * HTB)
#define PG8_SB(b, h) ((4 + (b) * 2 + (h)) * HTB)
#define PG8_STAGE(bufoff, gbase, voff) do { _Pragma("unroll") for (int _i = 0; _i < 2; ++_i) \
        __builtin_amdgcn_global_load_lds((const unsigned*)((const char*)(gbase) + (voff)[_i]), (PG8_LAS unsigned*)(lds + (bufoff) + ldsw + _i * 8192), 16, 0, 0); } while (0)
#define PG8_LDA(dst, b, h) do { _Pragma("unroll") for (int m = 0; m < 4; ++m) _Pragma("unroll") for (int k = 0; k < 2; ++k) dst[m][k] = *(const PG8_LAS bf16x8*)(lds + PG8_SA(b, h) + aoff + m * 2048 + k * 1024); } while (0)
#define PG8_LDB(dst, b, h) do { _Pragma("unroll") for (int n = 0; n < 2; ++n) _Pragma("unroll") for (int k = 0; k < 2; ++k) dst[n][k] = *(const PG8_LAS bf16x8*)(lds + PG8_SB(b, h) + boff + n * 2048 + k * 1024); } while (0)
#define PG8_MMA(ai, bj, At, Bt) do { __builtin_amdgcn_s_setprio(1); _Pragma("unroll") for (int m = 0; m < 4; ++m) _Pragma("unroll") for (int n = 0; n < 2; ++n) _Pragma("unroll") for (int k = 0; k < 2; ++k) \
        acc[ai][bj][m][n] = __builtin_amdgcn_mfma_f32_16x16x32_bf16(Bt[n][k], At[m][k], acc[ai][bj][m][n], 0, 0, 0); __builtin_amdgcn_s_setprio(0); } while (0)
#define PG8_WAIT_V(n) asm volatile("s_waitcnt vmcnt(" #n ")" ::: "memory")
#define PG8_WAIT_L(n) asm volatile("s_waitcnt lgkmcnt(" #n ")" ::: "memory")
#define PG8_BAR __builtin_amdgcn_s_barrier()
#define PG8_SCHED __builtin_amdgcn_sched_barrier(0)
    Unit cur, nxt; int ui = 0;
    if (!S.next(0, cur)) return;
    f32x4 acc[2][2][4][2];
#pragma unroll
    for (int a = 0; a < 2; ++a)
#pragma unroll
        for (int b = 0; b < 2; ++b)
#pragma unroll
            for (int m = 0; m < 4; ++m)
#pragma unroll
                for (int n = 0; n < 2; ++n) acc[a][b][m][n] = (f32x4){0.f, 0.f, 0.f, 0.f};
    bf16x8 At[4][2], B0[2][2], B1[2][2];
    const char* cA = (const char*)g.A + (size_t)cur.pm * tstep; const char* cB = (const char*)g.Bt + (size_t)cur.pn * tstep;
    S.a_ready(cur);
    if constexpr (SP2) {
        PG8_STAGE(PG8_SB(0, 0), cB, voffB); PG8_STAGE(PG8_SB(0, 1), cB + hstep, voffB); PG8_STAGE(PG8_SA(0, 0), cA, voffA); PG8_STAGE(PG8_SA(0, 1), cA + hstep, voffA);
        if (wr == 1) PG8_BAR;
        PG8_WAIT_V(2); PG8_BAR;
        PG8_STAGE(PG8_SB(1, 0), cB + kstep, voffB); PG8_STAGE(PG8_SA(1, 0), cA + kstep, voffA); PG8_STAGE(PG8_SB(1, 1), cB + hstep + kstep, voffB);
        PG8_WAIT_V(6); PG8_BAR;
    } else {
        PG8_STAGE(PG8_SB(0, 0), cB, voffB); PG8_STAGE(PG8_SA(0, 0), cA, voffA); PG8_STAGE(PG8_SB(0, 1), cB + hstep, voffB); PG8_STAGE(PG8_SA(0, 1), cA + hstep, voffA);
        if (wr == 1) PG8_BAR;
        PG8_WAIT_V(4); PG8_BAR;
        PG8_STAGE(PG8_SB(1, 0), cB + kstep, voffB); PG8_STAGE(PG8_SA(1, 0), cA + kstep, voffA); PG8_STAGE(PG8_SB(1, 1), cB + hstep + kstep, voffB);
        PG8_WAIT_V(6); PG8_BAR;
    }
    for (;;) {
        const bool has_next = S.next(ui + 1, nxt);
        const char* nA = has_next ? (const char*)g.A + (size_t)nxt.pm * tstep : cA; const char* nB = has_next ? (const char*)g.Bt + (size_t)nxt.pn * tstep : cB;
        for (int t = 0; t < nt; t += 2) {
            const bool last = (t == nt - 2);
            const char* a1 = cA + (size_t)(t + 1) * kstep;
            const char* a2 = last ? nA : cA + (size_t)(t + 2) * kstep; const char* b2 = last ? nB : cB + (size_t)(t + 2) * kstep;
            const char* a3 = a2 + kstep; const char* b3 = b2 + kstep;
            if (last && has_next) S.a_ready(nxt);
            if constexpr (SP2) {
            PG8_LDB(B0, 0, 0); PG8_LDB(B1, 0, 1); PG8_SCHED; PG8_LDA(At, 0, 0); PG8_STAGE(PG8_SA(1, 1), a1 + hstep, voffA);
            PG8_WAIT_V(8); PG8_WAIT_L(0); PG8_BAR; PG8_MMA(0, 0, At, B0); PG8_MMA(0, 1, At, B1); PG8_BAR; PG8_SCHED;
            PG8_LDA(At, 0, 1); PG8_STAGE(PG8_SB(0, 0), b2, voffB); PG8_STAGE(PG8_SB(0, 1), b2 + hstep, voffB); PG8_STAGE(PG8_SA(0, 0), a2, voffA);
            PG8_WAIT_V(8); PG8_WAIT_L(0); PG8_BAR; PG8_MMA(1, 0, At, B0); PG8_MMA(1, 1, At, B1); PG8_BAR; PG8_SCHED;
            PG8_LDB(B0, 1, 0); PG8_LDB(B1, 1, 1); PG8_SCHED; PG8_LDA(At, 1, 0); PG8_STAGE(PG8_SA(0, 1), a2 + hstep, voffA);
            PG8_WAIT_V(8); PG8_WAIT_L(0); PG8_BAR; PG8_MMA(0, 0, At, B0); PG8_MMA(0, 1, At, B1); PG8_BAR; PG8_SCHED;
            PG8_LDA(At, 1, 1); PG8_STAGE(PG8_SB(1, 0), b3, voffB); PG8_STAGE(PG8_SB(1, 1), b3 + hstep, voffB); PG8_STAGE(PG8_SA(1, 0), a3, voffA);
            PG8_WAIT_V(8); PG8_WAIT_L(0); PG8_BAR; PG8_MMA(1, 0, At, B0); PG8_MMA(1, 1, At, B1); PG8_BAR; PG8_SCHED;
            } else {
            PG8_LDB(B0, 0, 0); PG8_SCHED; PG8_LDA(At, 0, 0); PG8_STAGE(PG8_SA(1, 1), a1 + hstep, voffA);
            PG8_WAIT_L(8); PG8_BAR; PG8_WAIT_L(0); PG8_MMA(0, 0, At, B0); PG8_BAR; PG8_SCHED;
            PG8_LDB(B1, 0, 1); PG8_STAGE(PG8_SB(0, 0), b2, voffB);
            PG8_BAR; PG8_WAIT_L(0); PG8_MMA(0, 1, At, B1); PG8_BAR;
            PG8_LDA(At, 0, 1); PG8_STAGE(PG8_SA(0, 0), a2, voffA);
            PG8_BAR; PG8_WAIT_L(0); PG8_MMA(1, 0, At, B0); PG8_BAR; PG8_SCHED;
            PG8_STAGE(PG8_SB(0, 1), b2 + hstep, voffB);
            PG8_WAIT_V(6); PG8_BAR; PG8_MMA(1, 1, At, B1); PG8_BAR;
            PG8_LDB(B0, 1, 0); PG8_SCHED; PG8_LDA(At, 1, 0); PG8_STAGE(PG8_SA(0, 1), a2 + hstep, voffA);
            PG8_WAIT_L(8); PG8_BAR; PG8_WAIT_L(0); PG8_MMA(0, 0, At, B0); PG8_BAR; PG8_SCHED;
            PG8_LDB(B1, 1, 1); PG8_STAGE(PG8_SB(1, 0), b3, voffB);
            PG8_BAR; PG8_WAIT_L(0); PG8_MMA(0, 1, At, B1); PG8_BAR;
            PG8_LDA(At, 1, 1); PG8_STAGE(PG8_SA(1, 0), a3, voffA);
            PG8_BAR; PG8_WAIT_L(0); PG8_MMA(1, 0, At, B0); PG8_BAR; PG8_SCHED;
            PG8_STAGE(PG8_SB(1, 1), b3 + hstep, voffB);
            PG8_WAIT_V(6); PG8_BAR; PG8_MMA(1, 1, At, B1); PG8_BAR;
            }
        }
        if constexpr (ALIGN_EPI) { if (wr == 0) PG8_BAR; }
        if constexpr (!Epi::AFTER_DRAIN) { E(acc, cur, wr, wc, fr, fq); S.done(cur); }
        if (!has_next) break;
#pragma unroll
        for (int a = 0; a < 2; ++a)
#pragma unroll
            for (int b = 0; b < 2; ++b)
#pragma unroll
                for (int m = 0; m < 4; ++m)
#pragma unroll
                    for (int n = 0; n < 2; ++n) acc[a][b][m][n] = (f32x4){0.f, 0.f, 0.f, 0.f};
        cur = nxt; cA = nA; cB = nB; ++ui;
        if constexpr (ALIGN_EPI) { if (wr == 1) PG8_BAR; }
    }
    PG8_WAIT_V(0);
    if constexpr (!ALIGN_EPI) { if (wr == 0) PG8_BAR; }
    PG8_BAR;
    if constexpr (Epi::AFTER_DRAIN) { E.fused(acc, cur, wr, wc, fr, fq, lds, wid, lane); S.done(cur); }
#undef PG8_SA
#undef PG8_SB
#undef PG8_STAGE
#undef PG8_LDA
#undef PG8_LDB
#undef PG8_MMA
#undef PG8_WAIT_V
#undef PG8_WAIT_L
#undef PG8_BAR
#undef PG8_SCHED
}
}

#define LAS __attribute__((address_space(3)))
typedef unsigned short bf16;
typedef unsigned v4u __attribute__((ext_vector_type(4)));
typedef unsigned v2u __attribute__((ext_vector_type(2)));
typedef float f32x4 __attribute__((ext_vector_type(4)));
constexpr int D = 1024, BATCH = 16, SEQ = 2048, NTOK = BATCH * SEQ, CTXL = 256, NCTX = BATCH * CTXL, MROWS = NTOK + NCTX;
constexpr int GIN = 3104, GINP = 3328, KD = 512, VD = 1024, RANK = 16, HK = 128, HV = 256;
constexpr int FH = 2560, FUP = 5120, NMOD = 6144, MODROWS = 17;
constexpr float EPS = 1e-6f;
constexpr int NWAVES = 8, NTHREADS = 512;
constexpr int LDS_BYTES = 147456;
enum { I_X = 0, I_C, I_CTX, I_CCTX, I_ADAW, I_ADAB, I_NMIX, I_NFFN, I_GWIN, I_GWA2, I_GBA, I_GHN, I_GWOUT, I_SCWIN, I_SCCW, I_SCWOUT, I_FUP, I_FCW, I_FCB, I_FDN, I_FINAL, N_IN };
constexpr size_t MiB = 1u << 20;
constexpr size_t WS_CTL = 0, CTL_ZERO_BYTES = 1 * MiB;
constexpr size_t WS_MOD = 1 * MiB;
constexpr size_t WS_WIN = 2 * MiB;
constexpr size_t WS_WOUT = 9 * MiB;
constexpr size_t WS_SCIN = 11 * MiB;
constexpr size_t WS_SCOUT = 17 * MiB;
constexpr size_t WS_WUP = 19 * MiB;
constexpr size_t WS_WDN = 39 * MiB;
constexpr size_t WS_ALOW = 49 * MiB;
constexpr size_t WS_HN = 56 * MiB;
constexpr size_t WS_PROJ = 128 * MiB;
constexpr size_t WS_OF = 362 * MiB, WS_OB = 426 * MiB;
constexpr size_t WS_U = 128 * MiB;
constexpr size_t WS_ACT = 288 * MiB;
constexpr size_t WS_BCV = 128 * MiB;
constexpr size_t WS_END = 490 * MiB;

__device__ __forceinline__ unsigned f2bf(float f) { unsigned u = __builtin_bit_cast(unsigned, f); return (u + 0x7fffu + ((u >> 16) & 1u)) >> 16; }
__device__ __forceinline__ unsigned pk2(float lo, float hi) { return f2bf(lo) | (f2bf(hi) << 16); }
__device__ __forceinline__ float bflo(unsigned w) { return __builtin_bit_cast(float, w << 16); }
__device__ __forceinline__ float bfhi(unsigned w) { return __builtin_bit_cast(float, w & 0xffff0000u); }
__device__ __forceinline__ float bf2f(bf16 h) { return __builtin_bit_cast(float, ((unsigned)h) << 16); }
__device__ __forceinline__ float silu_f(float v) { return v / (1.0f + __expf(-v)); }
__device__ __forceinline__ float wave_sum(float v) {
#pragma unroll
    for (int o = 1; o < 64; o <<= 1) v += __shfl_xor(v, o);
    return v;
}
__device__ __forceinline__ void unpack8(const v4u w, float (&f)[8]) { f[0] = bflo(w.x); f[1] = bfhi(w.x); f[2] = bflo(w.y); f[3] = bfhi(w.y); f[4] = bflo(w.z); f[5] = bfhi(w.z); f[6] = bflo(w.w); f[7] = bfhi(w.w); }
__device__ __forceinline__ v4u pack8(const float (&f)[8]) { v4u w; w.x = pk2(f[0], f[1]); w.y = pk2(f[2], f[3]); w.z = pk2(f[4], f[5]); w.w = pk2(f[6], f[7]); return w; }

struct Params { const float* in[N_IN]; float* out; unsigned char* ws; int ph_lo, ph_hi; };

__device__ __forceinline__ void transpose_item(const float* W, int K, int N, bf16* WT, int k0, int n0, int rowbase, LAS float* scr, int lane) {
#pragma unroll 8
    for (int i = 0; i < 32; ++i) { const int kk = 2 * i + (lane >> 5); scr[kk * 33 + (lane & 31)] = W[(size_t)(k0 + kk) * N + n0 + (lane & 31)]; }
    asm volatile("s_waitcnt lgkmcnt(0)" ::: "memory");
    const int c = lane & 7;
#pragma unroll
    for (int j = 0; j < 4; ++j) { const int n = (lane >> 3) + 8 * j; const LAS float* s = scr + (8 * c) * 33 + n;
        v4u o; o.x = pk2(s[0 * 33], s[1 * 33]); o.y = pk2(s[2 * 33], s[3 * 33]); o.z = pk2(s[4 * 33], s[5 * 33]); o.w = pk2(s[6 * 33], s[7 * 33]);
        *(v4u*)(WT + (size_t)(rowbase + n) * K + k0 + 8 * c) = o; }
    asm volatile("s_waitcnt lgkmcnt(0)" ::: "memory");
}
__device__ __forceinline__ int uprow(int n) { return n < FH ? ((n >> 7) * 256 + (n & 127)) : ((((n - FH) >> 7) * 256) + 128 + ((n - FH) & 127)); }

__device__ __forceinline__ void phase_prep(const Params& P, LAS unsigned char* lds, int tid, int wave, int lane) {
    const int G = gridDim.x, gw = blockIdx.x * NWAVES + wave, NGW = G * NWAVES;
    unsigned char* ws = P.ws;
    LAS float* scr = (LAS float*)(lds + wave * 16384);
    constexpr int I_WIN = (D / 64) * (GIN / 32), I_WOUT = (D / 64) * (D / 32), I_SCIN = (D / 64) * (3 * D / 32), I_UP = (D / 64) * (FUP / 32), I_DN = (FH / 64) * (D / 32);
    constexpr int NITEMS = I_WIN + 2 * I_WOUT + I_SCIN + 2 * I_UP + 2 * I_DN;
    for (int it = gw; it < NITEMS; it += NGW) {
        int r = it;
        if (r < I_WIN) { const int nb = GIN / 32, kb = r / nb, n0 = 32 * (r % nb); transpose_item(P.in[I_GWIN], D, GIN, (bf16*)(ws + WS_WIN), 64 * kb, n0, n0, scr, lane); continue; } r -= I_WIN;
        if (r < I_WOUT) { const int nb = D / 32, kb = r / nb, n0 = 32 * (r % nb); transpose_item(P.in[I_GWOUT], D, D, (bf16*)(ws + WS_WOUT), 64 * kb, n0, n0, scr, lane); continue; } r -= I_WOUT;
        if (r < I_WOUT) { const int nb = D / 32, kb = r / nb, n0 = 32 * (r % nb); transpose_item(P.in[I_SCWOUT], D, D, (bf16*)(ws + WS_SCOUT), 64 * kb, n0, n0, scr, lane); continue; } r -= I_WOUT;
        if (r < I_SCIN) { const int nb = 3 * D / 32, kb = r / nb, n0 = 32 * (r % nb); transpose_item(P.in[I_SCWIN], D, 3 * D, (bf16*)(ws + WS_SCIN), 64 * kb, n0, n0, scr, lane); continue; } r -= I_SCIN;
        if (r < 2 * I_UP) { const int l = r / I_UP; r -= l * I_UP; const int nb = FUP / 32, kb = r / nb, n0 = 32 * (r % nb);
            transpose_item(P.in[I_FUP] + (size_t)l * D * FUP, D, FUP, (bf16*)(ws + WS_WUP) + (size_t)l * FUP * D, 64 * kb, n0, uprow(n0), scr, lane); continue; } r -= 2 * I_UP;
        { const int l = r / I_DN; r -= l * I_DN; const int nb = D / 32, kb = r / nb, n0 = 32 * (r % nb);
            transpose_item(P.in[I_FDN] + (size_t)l * FH * D, FH, D, (bf16*)(ws + WS_WDN) + (size_t)l * D * FH, 64 * kb, n0, n0, scr, lane); }
    }
    { v4u* z = (v4u*)((bf16*)(ws + WS_WIN) + (size_t)GIN * D); const int n16 = (GINP - GIN) * D * 2 / 16;
      for (int i = blockIdx.x * NTHREADS + tid; i < n16; i += G * NTHREADS) z[i] = (v4u){0u, 0u, 0u, 0u}; }
    __syncthreads();
    if ((int)blockIdx.x < 192) {
        LAS float* s = (LAS float*)lds;
        LAS float* red = s + MODROWS * D;
        for (int i = tid; i < MODROWS * D; i += NTHREADS) { const int b = i >> 10, k = i & 1023; const float cv = b < 16 ? P.in[I_C][b * D + k] : P.in[I_CCTX][k]; s[i] = silu_f(cv); }
        __syncthreads();
        float* MOD = (float*)(ws + WS_MOD);
        for (int it = blockIdx.x; it < 192; it += G) {
            const int layer = it / 96, cb = it % 96, col = cb * 64 + lane;
            const float* W = P.in[I_ADAW] + (size_t)layer * D * NMOD;
            float acc[MODROWS];
#pragma unroll
            for (int b = 0; b < MODROWS; ++b) acc[b] = 0.f;
            for (int k = wave * 128; k < wave * 128 + 128; k += 4) {
                const float w0 = W[(size_t)(k + 0) * NMOD + col], w1 = W[(size_t)(k + 1) * NMOD + col], w2 = W[(size_t)(k + 2) * NMOD + col], w3 = W[(size_t)(k + 3) * NMOD + col];
#pragma unroll
                for (int b = 0; b < MODROWS; ++b) { const f32x4 sv = *(const LAS f32x4*)(s + b * D + k); acc[b] += sv[0] * w0 + sv[1] * w1 + sv[2] * w2 + sv[3] * w3; }
            }
#pragma unroll
            for (int b = 0; b < MODROWS; ++b) red[(wave * MODROWS + b) * 64 + lane] = acc[b];
            __syncthreads();
            for (int o = tid; o < MODROWS * 64; o += NTHREADS) { const int b = o >> 6, l = o & 63; float sum = 0.f;
#pragma unroll
                for (int w = 0; w < NWAVES; ++w) sum += red[(w * MODROWS + b) * 64 + l];
                MOD[(size_t)(layer * MODROWS + b) * NMOD + cb * 64 + l] = sum + P.in[I_ADAB][layer * NMOD + cb * 64 + l]; }
            __syncthreads();
        }
    }
}

__device__ __forceinline__ void modulate_rows(const float* src, int nrows, int rows_per_b, int bfix, const float* gain, const float* mod, int shift_i, int scale_i, bf16* dst, int gw, int NGW, int lane) {
    for (int row = gw; row < nrows; row += NGW) {
        const int b = bfix >= 0 ? bfix : row / rows_per_b;
        const f32x4* xr = (const f32x4*)(src + (size_t)row * D) + lane;
        f32x4 v[4]; float ss = 0.f;
#pragma unroll
        for (int j = 0; j < 4; ++j) { v[j] = xr[64 * j]; ss += (v[j][0] * v[j][0] + v[j][1] * v[j][1]) + (v[j][2] * v[j][2] + v[j][3] * v[j][3]); }
        const float rstd = 1.0f / sqrtf(wave_sum(ss) * (1.0f / D) + EPS);
        const float* sh = mod + (size_t)b * NMOD + shift_i * D; const float* sc = mod + (size_t)b * NMOD + scale_i * D;
        v2u* o8 = (v2u*)(dst + (size_t)row * D) + lane;
#pragma unroll
        for (int j = 0; j < 4; ++j) { const int idx = 4 * lane + 256 * j; const f32x4 g = *(const f32x4*)(gain + idx), s4 = *(const f32x4*)(sh + idx), c4 = *(const f32x4*)(sc + idx);
            const f32x4 y = ((v[j] * rstd) * g) * (c4 + 1.0f) + s4; v2u w; w.x = pk2(y[0], y[1]); w.y = pk2(y[2], y[3]); o8[64 * j] = w; }
    }
}
__device__ __forceinline__ void final_norm_rows(float* h, const float* gain, int gw, int NGW, int lane) {
    for (int row = gw; row < NTOK; row += NGW) {
        f32x4* xr = (f32x4*)(h + (size_t)row * D) + lane;
        f32x4 v[4]; float ss = 0.f;
#pragma unroll
        for (int j = 0; j < 4; ++j) { v[j] = xr[64 * j]; ss += (v[j][0] * v[j][0] + v[j][1] * v[j][1]) + (v[j][2] * v[j][2] + v[j][3] * v[j][3]); }
        const float rstd = 1.0f / sqrtf(wave_sum(ss) * (1.0f / D) + EPS);
#pragma unroll
        for (int j = 0; j < 4; ++j) { const f32x4 g = *(const f32x4*)(gain + 4 * lane + 256 * j); xr[64 * j] = (v[j] * rstd) * g; }
    }
}

__device__ __forceinline__ void phase_scan_naive(const Params& P, LAS unsigned char* lds, int tid) {
    const int half = tid >> 8, t8 = tid & 255;
    LAS float* buf = (LAS float*)lds + half * 768;
    const bf16* PROJ = (const bf16*)(P.ws + WS_PROJ); const float* ALOW = (const float*)(P.ws + WS_ALOW);
    for (int it0 = blockIdx.x * 2; it0 < BATCH * 4 * 2; it0 += gridDim.x * 2) {
        const int item = it0 + half, b = item >> 3, h = (item >> 1) & 3, dir = item & 1;
        bf16* O = (bf16*)(P.ws + (dir ? WS_OB : WS_OF));
        float S[HK];
#pragma unroll
        for (int c = 0; c < HK; ++c) S[c] = 0.f;
        float w2[RANK], ba = 0.f;
#pragma unroll
        for (int r = 0; r < RANK; ++r) w2[r] = 0.f;
        if (t8 < HK) {
#pragma unroll
            for (int r = 0; r < RANK; ++r) w2[r] = P.in[I_GWA2][(dir * RANK + r) * KD + h * HK + t8];
            ba = P.in[I_GBA][dir * KD + h * HK + t8]; }
        for (int step = 0; step < CTXL + SEQ; ++step) {
            const bool isctx = step < CTXL; const int idx = isctx ? step : step - CTXL, n = isctx ? CTXL : SEQ, pos = dir ? n - 1 - idx : idx;
            const size_t row = isctx ? (size_t)NTOK + b * CTXL + pos : (size_t)b * SEQ + pos;
            LAS float* cur = buf + (step & 1) * 384;
            const bf16* pr = PROJ + row * GINP;
            if (t8 < HK) {
                const float q = bf2f(pr[h * HK + t8]) * 0.08838834764831845f, k = bf2f(pr[KD + h * HK + t8]);
                const float* al = ALOW + row * 32 + dir * RANK; float z = ba;
#pragma unroll
                for (int r = 0; r < RANK; ++r) z += al[r] * w2[r];
                const float ls = fminf(z, 0.f) - log1pf(expf(-fabsf(z)));
                cur[t8] = q; cur[128 + t8] = k; cur[256 + t8] = expf(ls * (1.0f / 16.0f));
            }
            const float v = bf2f(pr[2 * KD + h * HV + t8]);
            __syncthreads();
            float o = 0.f;
#pragma unroll
            for (int c = 0; c < HK; c += 4) { const f32x4 q4 = *(const LAS f32x4*)(cur + c), k4 = *(const LAS f32x4*)(cur + 128 + c), a4 = *(const LAS f32x4*)(cur + 256 + c);
#pragma unroll
                for (int j = 0; j < 4; ++j) { S[c + j] = a4[j] * S[c + j] + k4[j] * v; o += q4[j] * S[c + j]; } }
            if (!isctx) O[row * VD + h * HV + t8] = (bf16)f2bf(o);
        }
    }
}

__device__ __forceinline__ void phase_gate(const Params& P, int gw, int NGW, int lane) {
    const bf16* OF = (const bf16*)(P.ws + WS_OF); const bf16* OB = (const bf16*)(P.ws + WS_OB); const bf16* PROJ = (const bf16*)(P.ws + WS_PROJ); bf16* A = (bf16*)(P.ws + WS_HN);
    const float* hg = P.in[I_GHN] + ((16 * lane) & 255);
    float hgv[16];
#pragma unroll
    for (int i = 0; i < 16; ++i) hgv[i] = hg[i];
    for (int row = gw; row < NTOK; row += NGW) {
        const v4u* pf = (const v4u*)(OF + (size_t)row * VD + 16 * lane); const v4u* pb = (const v4u*)(OB + (size_t)row * VD + 16 * lane); const v4u* pg = (const v4u*)(PROJ + (size_t)row * GINP + 2 * KD + VD + 16 * lane);
        float o[16], t[8], g[16];
        unpack8(pf[0], t);
#pragma unroll
        for (int i = 0; i < 8; ++i) o[i] = t[i];
        unpack8(pf[1], t);
#pragma unroll
        for (int i = 0; i < 8; ++i) o[8 + i] = t[i];
        unpack8(pb[0], t);
#pragma unroll
        for (int i = 0; i < 8; ++i) o[i] += t[i];
        unpack8(pb[1], t);
#pragma unroll
        for (int i = 0; i < 8; ++i) o[8 + i] += t[i];
        unpack8(pg[0], t);
#pragma unroll
        for (int i = 0; i < 8; ++i) g[i] = t[i];
        unpack8(pg[1], t);
#pragma unroll
        for (int i = 0; i < 8; ++i) g[8 + i] = t[i];
        float ss = 0.f;
#pragma unroll
        for (int i = 0; i < 16; ++i) ss += o[i] * o[i];
        ss += __shfl_xor(ss, 1); ss += __shfl_xor(ss, 2); ss += __shfl_xor(ss, 4); ss += __shfl_xor(ss, 8);
        const float rstd = 1.0f / sqrtf(ss * (1.0f / HV) + EPS);
        float r0[8], r1[8];
#pragma unroll
        for (int i = 0; i < 8; ++i) { r0[i] = ((o[i] * rstd) * hgv[i]) * silu_f(g[i]); r1[i] = ((o[8 + i] * rstd) * hgv[8 + i]) * silu_f(g[8 + i]); }
        v4u* pa = (v4u*)(A + (size_t)row * D + 16 * lane); pa[0] = pack8(r0); pa[1] = pack8(r1);
    }
}

__device__ __forceinline__ void phase_convgate(const Params& P, int layer, int half, int gtid, int NT) {
    const bf16* U = (const bf16*)(P.ws + WS_U); bf16* ACT = (bf16*)(P.ws + WS_ACT);
    const float* cw = P.in[I_FCW] + (size_t)layer * 3 * FUP; const float* cb = P.in[I_FCB] + (size_t)layer * FUP;
    const int NITEM = NTOK * 160;
    for (int it = gtid; it < NITEM; it += NT) {
        const int t = it / 160, cg8 = it % 160, pnl = cg8 >> 4, j = (cg8 & 15) * 8, ch = (half * 10 + pnl) * 128 + j;
        const int gr = (t & (SEQ - 1)) >> 6;
        const bf16* ua = U + (size_t)t * FH + pnl * 256 + j; const bf16* ug = ua + 128;
        float a[8], g[8], tmp[8];
#pragma unroll
        for (int i = 0; i < 8; ++i) { a[i] = cb[ch + i]; g[i] = cb[FH + ch + i]; }
#pragma unroll
        for (int tap = 0; tap < 3; ++tap) {
            const int rr = gr + tap - 1; if (rr < 0 || rr > 31) continue;
            const long off = (long)(tap - 1) * 64 * FH;
            unpack8(*(const v4u*)(ua + off), tmp);
#pragma unroll
            for (int i = 0; i < 8; ++i) a[i] += tmp[i] * cw[tap * FUP + ch + i];
            unpack8(*(const v4u*)(ug + off), tmp);
#pragma unroll
            for (int i = 0; i < 8; ++i) g[i] += tmp[i] * cw[tap * FUP + FH + ch + i];
        }
        float r[8];
#pragma unroll
        for (int i = 0; i < 8; ++i) r[i] = a[i] * silu_f(g[i]);
        *(v4u*)(ACT + (size_t)t * FH + ch) = pack8(r);
    }
}
__device__ __forceinline__ void phase_scconv(const Params& P, int gtid, int NT) {
    const bf16* BCV = (const bf16*)(P.ws + WS_BCV); bf16* A = (bf16*)(P.ws + WS_HN);
    const float* cw = P.in[I_SCCW];
    const int NITEM = NTOK * 128;
    for (int it = gtid; it < NITEM; it += NT) {
        const int t = it >> 7, ch = (it & 127) * 8, col = t & 63;
        const bf16* p = BCV + (size_t)t * (3 * D) + ch;
        float acc[8], bgv[8], c8[8], v8[8];
#pragma unroll
        for (int i = 0; i < 8; ++i) acc[i] = 0.f;
#pragma unroll
        for (int tap = 0; tap < 3; ++tap) {
            const int cc = col + tap - 1; if (cc < 0 || cc > 63) continue;
            const long off = (long)(tap - 1) * 3 * D;
            unpack8(*(const v4u*)(p + off + D), c8); unpack8(*(const v4u*)(p + off + 2 * D), v8);
#pragma unroll
            for (int i = 0; i < 8; ++i) acc[i] += (c8[i] * v8[i]) * cw[tap * D + ch + i];
        }
        unpack8(*(const v4u*)p, bgv);
        float r[8];
#pragma unroll
        for (int i = 0; i < 8; ++i) r[i] = bgv[i] * acc[i];
        *(v4u*)(A + (size_t)t * D + ch) = pack8(r);
    }
}

enum { PH_PREP = 0, PH_MOD0, PH_GIN, PH_SCAN, PH_GATE, PH_GOUT, PH_FFN0  , PH_MOD1 = PH_FFN0 + 6, PH_SCIN, PH_SCCONV, PH_SCOUT, PH_FFN1, PH_FINAL = PH_FFN1 + 6, N_PHASES };

#define IN(k) (lo <= (k) && (k) < hi)
#define SEAM(k) do { if (IN(k) && IN((k) + 1)) { __syncthreads(); cg::this_grid().sync(); } } while (0)

__device__ __forceinline__ void ffn_block(const Params& P, LAS unsigned char* lds, int layer, int k0, int lo, int hi) {
    const int tid = threadIdx.x, lane = tid & 63, wave = __builtin_amdgcn_readfirstlane(tid >> 6);
    const int G = gridDim.x, gw = blockIdx.x * NWAVES + wave, NGW = G * NWAVES, gtid = blockIdx.x * NTHREADS + tid, NT = G * NTHREADS;
    unsigned char* ws = P.ws;
    const float* MODL = (const float*)(ws + WS_MOD) + (size_t)layer * MODROWS * NMOD;
    if (IN(k0)) modulate_rows(P.out, NTOK, SEQ, -1, P.in[I_NFFN] + layer * D, MODL, 3, 4, (bf16*)(ws + WS_HN), gw, NGW, lane);
    SEAM(k0);
#pragma unroll
    for (int half = 0; half < 2; ++half) {
        if (IN(k0 + 1 + 2 * half)) {
            pg8::Gemm g{(const bf16*)(ws + WS_HN), (const bf16*)(ws + WS_WUP) + (size_t)layer * FUP * D + (size_t)half * FH * D, NTOK, FH, D};
            pg8::StaticOrder S; S.init(g.M, g.N, G, (int)blockIdx.x);
            pg8::EpiBf16 E{(bf16*)(ws + WS_U), FH};
            pg8::gemm_phase<pg8::EpiBf16, pg8::StaticOrder, true, true>(lds, g, S, E);
        }
        SEAM(k0 + 1 + 2 * half);
        if (IN(k0 + 2 + 2 * half)) phase_convgate(P, layer, half, gtid, NT);
        SEAM(k0 + 2 + 2 * half);
    }
    if (IN(k0 + 5)) {
        pg8::Gemm g{(const bf16*)(ws + WS_ACT), (const bf16*)(ws + WS_WDN) + (size_t)layer * D * FH, NTOK, D, FH};
        pg8::StaticOrder S; S.init(g.M, g.N, G, (int)blockIdx.x);
        pg8::EpiResid E{P.out, P.out, MODL + 5 * D, NMOD, SEQ, D};
        pg8::gemm_phase<pg8::EpiResid, pg8::StaticOrder, true, true>(lds, g, S, E);
    }
    SEAM(k0 + 5);
}

__global__ void __launch_bounds__(NTHREADS, 2) fwd_kernel(Params P) {
    extern __shared__ __attribute__((aligned(16))) unsigned char lds_raw[];
    LAS unsigned char* lds = (LAS unsigned char*)lds_raw;
    const int tid = threadIdx.x, lane = tid & 63, wave = __builtin_amdgcn_readfirstlane(tid >> 6);
    const int G = gridDim.x, gw = blockIdx.x * NWAVES + wave, NGW = G * NWAVES, gtid = blockIdx.x * NTHREADS + tid, NT = G * NTHREADS;
    unsigned char* ws = P.ws;
    const int lo = P.ph_lo, hi = P.ph_hi;
    const float* MOD = (const float*)(ws + WS_MOD);
    bf16* HN = (bf16*)(ws + WS_HN);

    if (IN(PH_PREP)) phase_prep(P, lds, tid, wave, lane);
    SEAM(PH_PREP);
    if (IN(PH_MOD0)) {
        modulate_rows(P.in[I_X], NTOK, SEQ, -1, P.in[I_NMIX], MOD, 0, 1, HN, gw, NGW, lane);
        modulate_rows(P.in[I_CTX], NCTX, CTXL, 16, P.in[I_NMIX], MOD, 0, 1, HN + (size_t)NTOK * D, gw, NGW, lane);
    }
    SEAM(PH_MOD0);
    if (IN(PH_GIN)) {
        pg8::Gemm g{HN, (const bf16*)(ws + WS_WIN), MROWS, GINP, D};
        pg8::StaticOrder S; S.init(g.M, g.N, G, (int)blockIdx.x);
        pg8::EpiProj E{(bf16*)(ws + WS_PROJ), GINP, (float*)(ws + WS_ALOW), 12};
        pg8::gemm_phase<pg8::EpiProj, pg8::StaticOrder, true, true>(lds, g, S, E);
    }
    SEAM(PH_GIN);
    if (IN(PH_SCAN)) phase_scan_naive(P, lds, tid);
    SEAM(PH_SCAN);
    if (IN(PH_GATE)) phase_gate(P, gw, NGW, lane);
    SEAM(PH_GATE);
    if (IN(PH_GOUT)) {
        pg8::Gemm g{HN, (const bf16*)(ws + WS_WOUT), NTOK, D, D};
        pg8::StaticOrder S; S.init(g.M, g.N, G, (int)blockIdx.x);
        pg8::EpiResid E{P.in[I_X], P.out, MOD + 2 * D, NMOD, SEQ, D};
        pg8::gemm_phase<pg8::EpiResid, pg8::StaticOrder, true, true>(lds, g, S, E);
    }
    SEAM(PH_GOUT);
    ffn_block(P, lds, 0, PH_FFN0, lo, hi);
    if (IN(PH_MOD1)) modulate_rows(P.out, NTOK, SEQ, -1, P.in[I_NMIX] + D, MOD + (size_t)MODROWS * NMOD, 0, 1, HN, gw, NGW, lane);
    SEAM(PH_MOD1);
    if (IN(PH_SCIN)) {
        pg8::Gemm g{HN, (const bf16*)(ws + WS_SCIN), NTOK, 3 * D, D};
        pg8::StaticOrder S; S.init(g.M, g.N, G, (int)blockIdx.x);
        pg8::EpiBf16 E{(bf16*)(ws + WS_BCV), 3 * D};
        pg8::gemm_phase<pg8::EpiBf16, pg8::StaticOrder, true, true>(lds, g, S, E);
    }
    SEAM(PH_SCIN);
    if (IN(PH_SCCONV)) phase_scconv(P, gtid, NT);
    SEAM(PH_SCCONV);
    if (IN(PH_SCOUT)) {
        pg8::Gemm g{HN, (const bf16*)(ws + WS_SCOUT), NTOK, D, D};
        pg8::StaticOrder S; S.init(g.M, g.N, G, (int)blockIdx.x);
        pg8::EpiResid E{P.out, P.out, MOD + (size_t)MODROWS * NMOD + 2 * D, NMOD, SEQ, D};
        pg8::gemm_phase<pg8::EpiResid, pg8::StaticOrder, true, true>(lds, g, S, E);
    }
    SEAM(PH_SCOUT);
    ffn_block(P, lds, 1, PH_FFN1, lo, hi);
    if (IN(PH_FINAL)) final_norm_rows(P.out, P.in[I_FINAL], gw, NGW, lane);
}
#undef IN
#undef SEAM

#ifndef MK_ONE_LAUNCH
#define MK_ONE_LAUNCH 1
#endif
extern "C" void kernel_launch(void* const* d_in, const int* in_sizes, int n_in, void* d_out, int out_size, void* d_ws, size_t ws_size, hipStream_t stream) {
    static int grid = 0;
    if (grid == 0) {
        if (n_in != N_IN || out_size != NTOK * D || ws_size < WS_END) { fprintf(stderr, "kernel_launch: unexpected shapes (n_in %d out %d ws %zu)\n", n_in, out_size, ws_size); grid = -1; return; }
        int dev = 0, cus = 0, per_cu = 0;
        if (hipGetDevice(&dev) != hipSuccess || hipDeviceGetAttribute(&cus, hipDeviceAttributeMultiprocessorCount, dev) != hipSuccess) { grid = -1; return; }
        if (hipFuncSetAttribute((const void*)fwd_kernel, hipFuncAttributeMaxDynamicSharedMemorySize, LDS_BYTES) != hipSuccess) { fprintf(stderr, "kernel_launch: hipFuncSetAttribute failed\n"); grid = -1; return; }
        if (hipOccupancyMaxActiveBlocksPerMultiprocessor(&per_cu, (const void*)fwd_kernel, NTHREADS, LDS_BYTES) != hipSuccess || per_cu < 1) { fprintf(stderr, "kernel_launch: occupancy query says %d\n", per_cu); per_cu = 1; }
        (void)hipGetLastError();
        grid = cus;
    }
    if (grid < 0) return;
    (void)hipMemsetAsync((char*)d_ws + WS_CTL, 0, CTL_ZERO_BYTES, stream);
    Params p{};
    for (int i = 0; i < N_IN; ++i) p.in[i] = (const float*)d_in[i];
    p.out = (float*)d_out; p.ws = (unsigned char*)d_ws;
#if MK_ONE_LAUNCH
    p.ph_lo = 0; p.ph_hi = N_PHASES;
    void* args[] = {&p};
    hipError_t e = hipLaunchCooperativeKernel((const void*)fwd_kernel, dim3(grid), dim3(NTHREADS), args, LDS_BYTES, stream);
    if (e != hipSuccess) fprintf(stderr, "cooperative launch failed: %s (grid %d)\n", hipGetErrorString(e), grid);
#else
    for (int ph = 0; ph < N_PHASES; ++ph) { p.ph_lo = ph; p.ph_hi = ph + 1; hipLaunchKernelGGL(fwd_kernel, dim3(grid), dim3(NTHREADS), LDS_BYTES, stream, p); }
#endif
}
```

```cpp
#include <hip/hip_runtime.h>
#include <hip/hip_cooperative_groups.h>
#include <cstdio>
#include <cstdint>
namespace cg = cooperative_groups;
namespace pg8 {
#define PG8_LAS __attribute__((address_space(3)))
typedef unsigned short bf16_t;
typedef short bf16x8 __attribute__((ext_vector_type(8)));
typedef float f32x4 __attribute__((ext_vector_type(4)));
typedef unsigned u32x4 __attribute__((ext_vector_type(4)));
constexpr int BM = 256, BK = 64, HALF = 128, HTB = HALF * BK * 2  , STAGE_BYTES = 8 * HTB, NXCD = 8, WGM = 8;

__host__ __device__ __forceinline__ int lds_byte(int r, int c) { const int st = (r >> 4) * 2 + (c >> 5), rr = r & 15, cc = c & 31, ob = rr * 64 + cc * 2; return st * 1024 + (ob ^ (((ob >> 9) & 1) << 5)); }
__host__ __device__ __forceinline__ void stage_rc(int b, int& R, int& C) { const int st = b / 1024, sb = b % 1024, swz = sb ^ (((sb >> 9) & 1) << 5); R = (st >> 1) * 16 + swz / 64; C = (st & 1) * 32 + (swz % 64) / 2; }
__host__ __device__ __forceinline__ int perm32(int rho) { const int n = rho >> 4, i = rho & 15; return 8 * (i >> 2) + 4 * n + (i & 3); }

struct Unit { int pm, pn; };
struct Gemm { const bf16_t* A; const bf16_t* Bt; int M, N, K; };

struct StaticOrder {
    int nM, nN, nwg, G, c;
    __host__ __device__ void init(int M, int N, int G_, int c_) { nM = M / BM; nN = N / BM; nwg = nM * nN; G = G_; c = c_; }
    __host__ __device__ bool next(int i, Unit& u) const {
        const long L = (long)i * G + c; if (L >= nwg) return false;
        int wgid = (int)L; { const int q = nwg / NXCD, r = nwg % NXCD, xcd = wgid % NXCD, off = wgid / NXCD; wgid = (xcd < r ? xcd * (q + 1) : r * (q + 1) + (xcd - r) * q) + off; }
        const int nig = WGM * nN, gid = wgid / nig, fm = gid * WGM, gsz = (nM - fm) < WGM ? (nM - fm) : WGM;
        u.pm = fm + ((wgid % nig) % gsz); u.pn = (wgid % nig) / gsz; return true;
    }
    __device__ __forceinline__ void a_ready(const Unit&) const {}
    __device__ __forceinline__ void done(const Unit&) const {}
};


__device__ __forceinline__ unsigned cvt_pk_bf16(float lo, float hi) { unsigned r; asm volatile("v_cvt_pk_bf16_f32 %0, %1, %2" : "=v"(r) : "v"(lo), "v"(hi)); return r; }

struct EpiBf16 {
    static constexpr bool PERM = true, AFTER_DRAIN = false;
    bf16_t* O; int ldc;
    __device__ __forceinline__ void operator()(const f32x4 (&acc)[2][2][4][2], const Unit& u, int wr, int wc, int fr, int fq) const {
        const int row0 = u.pm * BM + wr * 64 + fr; const int col0 = u.pn * BM + wc * 32 + 8 * fq;
#pragma unroll
        for (int ai = 0; ai < 2; ++ai)
#pragma unroll
            for (int m = 0; m < 4; ++m) { bf16_t* rowp = O + (size_t)(row0 + ai * HALF + m * 16) * ldc + col0;
#pragma unroll
                for (int bj = 0; bj < 2; ++bj) { const f32x4 v0 = acc[ai][bj][m][0], v1 = acc[ai][bj][m][1];
                    u32x4 w; w.x = cvt_pk_bf16(v0[0], v0[1]); w.y = cvt_pk_bf16(v0[2], v0[3]); w.z = cvt_pk_bf16(v1[0], v1[1]); w.w = cvt_pk_bf16(v1[2], v1[3]);
                    *(u32x4*)(rowp + bj * HALF) = w; } }
    }
};
struct EpiProj {
    static constexpr bool PERM = true, AFTER_DRAIN = false;
    bf16_t* O; int ldc; float* alow; int pn_low;
    __device__ __forceinline__ void operator()(const f32x4 (&acc)[2][2][4][2], const Unit& u, int wr, int wc, int fr, int fq) const {
        const int row0 = u.pm * BM + wr * 64 + fr; const int col0 = u.pn * BM + wc * 32 + 8 * fq;
#pragma unroll
        for (int ai = 0; ai < 2; ++ai)
#pragma unroll
            for (int m = 0; m < 4; ++m) { bf16_t* rowp = O + (size_t)(row0 + ai * HALF + m * 16) * ldc + col0;
#pragma unroll
                for (int bj = 0; bj < 2; ++bj) { const f32x4 v0 = acc[ai][bj][m][0], v1 = acc[ai][bj][m][1];
                    u32x4 w; w.x = cvt_pk_bf16(v0[0], v0[1]); w.y = cvt_pk_bf16(v0[2], v0[3]); w.z = cvt_pk_bf16(v1[0], v1[1]); w.w = cvt_pk_bf16(v1[2], v1[3]);
                    *(u32x4*)(rowp + bj * HALF) = w; } }
        if (u.pn == pn_low && wc == 0) {
#pragma unroll
            for (int ai = 0; ai < 2; ++ai)
#pragma unroll
                for (int m = 0; m < 4; ++m) { float* ap = alow + (size_t)(row0 + ai * HALF + m * 16) * 32 + 8 * fq;
                    *(f32x4*)(ap) = acc[ai][0][m][0]; *(f32x4*)(ap + 4) = acc[ai][0][m][1]; }
        }
    }
};
struct EpiResid {
    static constexpr bool PERM = false, AFTER_DRAIN = false;
    const float* base; float* out; const float* gate; int gstride; int rows_per_b; int ldc;
    __device__ __forceinline__ void operator()(const f32x4 (&acc)[2][2][4][2], const Unit& u, int wr, int wc, int fr, int fq) const {
        const int row0 = u.pm * BM + wr * 64 + fr, col0 = u.pn * BM + wc * 32 + 4 * fq;
        const int b = (u.pm * BM) / rows_per_b;
        f32x4 gv[2][2];
#pragma unroll
        for (int bj = 0; bj < 2; ++bj)
#pragma unroll
            for (int n = 0; n < 2; ++n) gv[bj][n] = *(const f32x4*)(gate + (size_t)b * gstride + col0 + bj * HALF + n * 16);
#pragma unroll
        for (int ai = 0; ai < 2; ++ai)
#pragma unroll
            for (int m = 0; m < 4; ++m) { const size_t off = (size_t)(row0 + ai * HALF + m * 16) * ldc + col0;
#pragma unroll
                for (int bj = 0; bj < 2; ++bj)
#pragma unroll
                    for (int n = 0; n < 2; ++n) { const f32x4 bs = *(const f32x4*)(base + off + bj * HALF + n * 16);
                        *(f32x4*)(out + off + bj * HALF + n * 16) = bs + gv[bj][n] * acc[ai][bj][m][n]; } }
    }
};

template <class Epi, class Sched, bool ALIGN_EPI = false, bool SP2 = false>
__device__ __forceinline__ void gemm_phase(PG8_LAS unsigned char* lds, const Gemm g, const Sched& S, const Epi& E) {
    const int tid = threadIdx.x, wid = __builtin_amdgcn_readfirstlane(tid >> 6), lane = tid & 63, wr = wid >> 2, wc = wid & 3, fr = lane & 15, fq = lane >> 4;
    const int K = g.K, nt = K / BK;
    unsigned voffA[2], voffB[2];
#pragma unroll
    for (int i = 0; i < 2; ++i) { int R, C; stage_rc(tid * 16 + i * 8192, R, C); const int Rb = Epi::PERM ? ((R & ~31) + perm32(R & 31)) : R;
        voffA[i] = (unsigned)(R * K + C) * 2u; voffB[i] = (unsigned)(Rb * K + C) * 2u; }
    const size_t kstep = (size_t)(BK * 2);
    const size_t hstep = (size_t)HALF * K * 2;
    const size_t tstep = 2 * hstep;
    const unsigned ldsw = (unsigned)wid * 1024u;
    const int aoff = lds_byte(wr * 64 + fr, fq * 8), boff = lds_byte(wc * 32 + fr, fq * 8);
#define PG8_SA(b, h) (((b) * 2 + (h)) * HTB)
#define PG8_SB(b, h) ((4 + (b) * 2 + (h)) * HTB)
#define PG8_STAGE(bufoff, gbase, voff) do { _Pragma("unroll") for (int _i = 0; _i < 2; ++_i) \
        __builtin_amdgcn_global_load_lds((const unsigned*)((const char*)(gbase) + (voff)[_i]), (PG8_LAS unsigned*)(lds + (bufoff) + ldsw + _i * 8192), 16, 0, 0); } while (0)
#define PG8_LDA(dst, b, h) do { _Pragma("unroll") for (int m = 0; m < 4; ++m) _Pragma("unroll") for (int k = 0; k < 2; ++k) dst[m][k] = *(const PG8_LAS bf16x8*)(lds + PG8_SA(b, h) + aoff + m * 2048 + k * 1024); } while (0)
#define PG8_LDB(dst, b, h) do { _Pragma("unroll") for (int n = 0; n < 2; ++n) _Pragma("unroll") for (int k = 0; k < 2; ++k) dst[n][k] = *(const PG8_LAS bf16x8*)(lds + PG8_SB(b, h) + boff + n * 2048 + k * 1024); } while (0)
#define PG8_MMA(ai, bj, At, Bt) do { __builtin_amdgcn_s_setprio(1); _Pragma("unroll") for (int m = 0; m < 4; ++m) _Pragma("unroll") for (int n = 0; n < 2; ++n) _Pragma("unroll") for (int k = 0; k < 2; ++k) \
        acc[ai][bj][m][n] = __builtin_amdgcn_mfma_f32_16x16x32_bf16(Bt[n][k], At[m][k], acc[ai][bj][m][n], 0, 0, 0); __builtin_amdgcn_s_setprio(0); } while (0)
#define PG8_WAIT_V(n) asm volatile("s_waitcnt vmcnt(" #n ")" ::: "memory")
#define PG8_WAIT_L(n) asm volatile("s_waitcnt lgkmcnt(" #n ")" ::: "memory")
#define PG8_BAR __builtin_amdgcn_s_barrier()
#define PG8_SCHED __builtin_amdgcn_sched_barrier(0)
    Unit cur, nxt; int ui = 0;
    if (!S.next(0, cur)) return;
    f32x4 acc[2][2][4][2];
#pragma unroll
    for (int a = 0; a < 2; ++a)
#pragma unroll
        for (int b = 0; b < 2; ++b)
#pragma unroll
            for (int m = 0; m < 4; ++m)
#pragma unroll
                for (int n = 0; n < 2; ++n) acc[a][b][m][n] = (f32x4){0.f, 0.f, 0.f, 0.f};
    bf16x8 At[4][2], B0[2][2], B1[2][2];
    const char* cA = (const char*)g.A + (size_t)cur.pm * tstep; const char* cB = (const char*)g.Bt + (size_t)cur.pn * tstep;
    S.a_ready(cur);
    if constexpr (SP2) {
        PG8_STAGE(PG8_SB(0, 0), cB, voffB); PG8_STAGE(PG8_SB(0, 1), cB + hstep, voffB); PG8_STAGE(PG8_SA(0, 0), cA, voffA); PG8_STAGE(PG8_SA(0, 1), cA + hstep, voffA);
        if (wr == 1) PG8_BAR;
        PG8_WAIT_V(2); PG8_BAR;
        PG8_STAGE(PG8_SB(1, 0), cB + kstep, voffB); PG8_STAGE(PG8_SA(1, 0), cA + kstep, voffA); PG8_STAGE(PG8_SB(1, 1), cB + hstep + kstep, voffB);
        PG8_WAIT_V(6); PG8_BAR;
    } else {
        PG8_STAGE(PG8_SB(0, 0), cB, voffB); PG8_STAGE(PG8_SA(0, 0), cA, voffA); PG8_STAGE(PG8_SB(0, 1), cB + hstep, voffB); PG8_STAGE(PG8_SA(0, 1), cA + hstep, voffA);
        if (wr == 1) PG8_BAR;
        PG8_WAIT_V(4); PG8_BAR;
        PG8_STAGE(PG8_SB(1, 0), cB + kstep, voffB); PG8_STAGE(PG8_SA(1, 0), cA + kstep, voffA); PG8_STAGE(PG8_SB(1, 1), cB + hstep + kstep, voffB);
        PG8_WAIT_V(6); PG8_BAR;
    }
    for (;;) {
        const bool has_next = S.next(ui + 1, nxt);
        const char* nA = has_next ? (const char*)g.A + (size_t)nxt.pm * tstep : cA; const char* nB = has_next ? (const char*)g.Bt + (size_t)nxt.pn * tstep : cB;
        for (int t = 0; t < nt; t += 2) {
            const bool last = (t == nt - 2);
            const char* a1 = cA + (size_t)(t + 1) * kstep;
            const char* a2 = last ? nA : cA + (size_t)(t + 2) * kstep; const char* b2 = last ? nB : cB + (size_t)(t + 2) * kstep;
            const char* a3 = a2 + kstep; const char* b3 = b2 + kstep;
            if (last && has_next) S.a_ready(nxt);
            if constexpr (SP2) {
            PG8_LDB(B0, 0, 0); PG8_LDB(B1, 0, 1); PG8_SCHED; PG8_LDA(At, 0, 0); PG8_STAGE(PG8_SA(1, 1), a1 + hstep, voffA);
            PG8_WAIT_V(8); PG8_WAIT_L(0); PG8_BAR; PG8_MMA(0, 0, At, B0); PG8_MMA(0, 1, At, B1); PG8_BAR; PG8_SCHED;
            PG8_LDA(At, 0, 1); PG8_STAGE(PG8_SB(0, 0), b2, voffB); PG8_STAGE(PG8_SB(0, 1), b2 + hstep, voffB); PG8_STAGE(PG8_SA(0, 0), a2, voffA);
            PG8_WAIT_V(8); PG8_WAIT_L(0); PG8_BAR; PG8_MMA(1, 0, At, B0); PG8_MMA(1, 1, At, B1); PG8_BAR; PG8_SCHED;
            PG8_LDB(B0, 1, 0); PG8_LDB(B1, 1, 1); PG8_SCHED; PG8_LDA(At, 1, 0); PG8_STAGE(PG8_SA(0, 1), a2 + hstep, voffA);
            PG8_WAIT_V(8); PG8_WAIT_L(0); PG8_BAR; PG8_MMA(0, 0, At, B0); PG8_MMA(0, 1, At, B1); PG8_BAR; PG8_SCHED;
            PG8_LDA(At, 1, 1); PG8_STAGE(PG8_SB(1, 0), b3, voffB); PG8_STAGE(PG8_SB(1, 1), b3 + hstep, voffB); PG8_STAGE(PG8_SA(1, 0), a3, voffA);
            PG8_WAIT_V(8); PG8_WAIT_L(0); PG8_BAR; PG8_MMA(1, 0, At, B0); PG8_MMA(1, 1, At, B1); PG8_BAR; PG8_SCHED;
            } else {
            PG8_LDB(B0, 0, 0); PG8_SCHED; PG8_LDA(At, 0, 0); PG8_STAGE(PG8_SA(1, 1), a1 + hstep, voffA);
            PG8_WAIT_L(8); PG8_BAR; PG8_WAIT_L(0); PG8_MMA(0, 0, At, B0); PG8_BAR; PG8_SCHED;
            PG8_LDB(B1, 0, 1); PG8_STAGE(PG8_SB(0, 0), b2, voffB);
            PG8_BAR; PG8_WAIT_L(0); PG8_MMA(0, 1, At, B1); PG8_BAR;
            PG8_LDA(At, 0, 1); PG8_STAGE(PG8_SA(0, 0), a2, voffA);
            PG8_BAR; PG8_WAIT_L(0); PG8_MMA(1, 0, At, B0); PG8_BAR; PG8_SCHED;
            PG8_STAGE(PG8_SB(0, 1), b2 + hstep, voffB);
            PG8_WAIT_V(6); PG8_BAR; PG8_MMA(1, 1, At, B1); PG8_BAR;
            PG8_LDB(B0, 1, 0); PG8_SCHED; PG8_LDA(At, 1, 0); PG8_STAGE(PG8_SA(0, 1), a2 + hstep, voffA);
            PG8_WAIT_L(8); PG8_BAR; PG8_WAIT_L(0); PG8_MMA(0, 0, At, B0); PG8_BAR; PG8_SCHED;
            PG8_LDB(B1, 1, 1); PG8_STAGE(PG8_SB(1, 0), b3, voffB);
            PG8_BAR; PG8_WAIT_L(0); PG8_MMA(0, 1, At, B1); PG8_BAR;
            PG8_LDA(At, 1, 1); PG8_STAGE(PG8_SA(1, 0), a3, voffA);
            PG8_BAR; PG8_WAIT_L(0); PG8_MMA(1, 0, At, B0); PG8_BAR; PG8_SCHED;
            PG8_STAGE(PG8_SB(1, 1), b3 + hstep, voffB);
            PG8_WAIT_V(6); PG8_BAR; PG8_MMA(1, 1, At, B1); PG8_BAR;
            }
        }
        if constexpr (ALIGN_EPI) { if (wr == 0) PG8_BAR; }
        if constexpr (!Epi::AFTER_DRAIN) { E(acc, cur, wr, wc, fr, fq); S.done(cur); }
        if (!has_next) break;
#pragma unroll
        for (int a = 0; a < 2; ++a)
#pragma unroll
            for (int b = 0; b < 2; ++b)
#pragma unroll
                for (int m = 0; m < 4; ++m)
#pragma unroll
                    for (int n = 0; n < 2; ++n) acc[a][b][m][n] = (f32x4){0.f, 0.f, 0.f, 0.f};
        cur = nxt; cA = nA; cB = nB; ++ui;
        if constexpr (ALIGN_EPI) { if (wr == 1) PG8_BAR; }
    }
    PG8_WAIT_V(0);
    if constexpr (!ALIGN_EPI) { if (wr == 0) PG8_BAR; }
    PG8_BAR;
    if constexpr (Epi::AFTER_DRAIN) { E.fused(acc, cur, wr, wc, fr, fq, lds, wid, lane); S.done(cur); }
#undef PG8_SA
#undef PG8_SB
#undef PG8_STAGE
#undef PG8_LDA
#undef PG8_LDB
#undef PG8_MMA
#undef PG8_WAIT_V
#undef PG8_WAIT_L
#undef PG8_BAR
#undef PG8_SCHED
}
}

#define LAS __attribute__((address_space(3)))
typedef unsigned short bf16;
typedef unsigned v4u __attribute__((ext_vector_type(4)));
typedef unsigned v2u __attribute__((ext_vector_type(2)));
typedef float f32x4 __attribute__((ext_vector_type(4)));
constexpr int D = 1024, BATCH = 16, SEQ = 2048, NTOK = BATCH * SEQ, CTXL = 256, NCTX = BATCH * CTXL, MROWS = NTOK + NCTX;
constexpr int GIN = 3104, GINP = 3328, KD = 512, VD = 1024, RANK = 16, HK = 128, HV = 256;
constexpr int FH = 2560, FUP = 5120, NMOD = 6144, MODROWS = 17;
constexpr float EPS = 1e-6f;
constexpr int NWAVES = 8, NTHREADS = 512;
constexpr int LDS_BYTES = 159744;
enum { I_X = 0, I_C, I_CTX, I_CCTX, I_ADAW, I_ADAB, I_NMIX, I_NFFN, I_GWIN, I_GWA2, I_GBA, I_GHN, I_GWOUT, I_SCWIN, I_SCCW, I_SCWOUT, I_FUP, I_FCW, I_FCB, I_FDN, I_FINAL, N_IN };
constexpr size_t MiB = 1u << 20;
constexpr size_t WS_CTL = 0, CTL_ZERO_BYTES = 1 * MiB;
constexpr size_t WS_MOD = 1 * MiB;
constexpr size_t WS_WIN = 2 * MiB;
constexpr size_t WS_WOUT = 9 * MiB;
constexpr size_t WS_SCIN = 11 * MiB;
constexpr size_t WS_SCOUT = 17 * MiB;
constexpr size_t WS_WUP = 19 * MiB;
constexpr size_t WS_WDN = 39 * MiB;
constexpr size_t WS_ALOW = 49 * MiB;
constexpr size_t WS_HN = 56 * MiB;
constexpr size_t WS_PROJ = 128 * MiB;
constexpr size_t WS_OF = 362 * MiB, WS_OB = 426 * MiB;
constexpr size_t WS_U = 128 * MiB;
constexpr size_t WS_ACT = 288 * MiB;
constexpr size_t WS_BCV = 128 * MiB;
constexpr size_t WS_END = 490 * MiB;

__device__ __forceinline__ unsigned f2bf(float f) { unsigned u = __builtin_bit_cast(unsigned, f); return (u + 0x7fffu + ((u >> 16) & 1u)) >> 16; }
__device__ __forceinline__ unsigned pk2(float lo, float hi) { return f2bf(lo) | (f2bf(hi) << 16); }
__device__ __forceinline__ float bflo(unsigned w) { return __builtin_bit_cast(float, w << 16); }
__device__ __forceinline__ float bfhi(unsigned w) { return __builtin_bit_cast(float, w & 0xffff0000u); }
__device__ __forceinline__ float bf2f(bf16 h) { return __builtin_bit_cast(float, ((unsigned)h) << 16); }
__device__ __forceinline__ float silu_f(float v) { return v / (1.0f + __expf(-v)); }
__device__ __forceinline__ float wave_sum(float v) {
#pragma unroll
    for (int o = 1; o < 64; o <<= 1) v += __shfl_xor(v, o);
    return v;
}
__device__ __forceinline__ void unpack8(const v4u w, float (&f)[8]) { f[0] = bflo(w.x); f[1] = bfhi(w.x); f[2] = bflo(w.y); f[3] = bfhi(w.y); f[4] = bflo(w.z); f[5] = bfhi(w.z); f[6] = bflo(w.w); f[7] = bfhi(w.w); }
__device__ __forceinline__ v4u pack8(const float (&f)[8]) { v4u w; w.x = pk2(f[0], f[1]); w.y = pk2(f[2], f[3]); w.z = pk2(f[4], f[5]); w.w = pk2(f[6], f[7]); return w; }

struct Params { const float* in[N_IN]; float* out; unsigned char* ws; int ph_lo, ph_hi; };

__device__ __forceinline__ void transpose_item(const float* W, int K, int N, bf16* WT, int k0, int n0, int rowbase, LAS float* scr, int lane) {
#pragma unroll 8
    for (int i = 0; i < 32; ++i) { const int kk = 2 * i + (lane >> 5); scr[kk * 33 + (lane & 31)] = W[(size_t)(k0 + kk) * N + n0 + (lane & 31)]; }
    asm volatile("s_waitcnt lgkmcnt(0)" ::: "memory");
    const int c = lane & 7;
#pragma unroll
    for (int j = 0; j < 4; ++j) { const int n = (lane >> 3) + 8 * j; const LAS float* s = scr + (8 * c) * 33 + n;
        v4u o; o.x = pk2(s[0 * 33], s[1 * 33]); o.y = pk2(s[2 * 33], s[3 * 33]); o.z = pk2(s[4 * 33], s[5 * 33]); o.w = pk2(s[6 * 33], s[7 * 33]);
        *(v4u*)(WT + (size_t)(rowbase + n) * K + k0 + 8 * c) = o; }
    asm volatile("s_waitcnt lgkmcnt(0)" ::: "memory");
}
__device__ __forceinline__ int uprow(int n) { return n < FH ? ((n >> 7) * 256 + (n & 127)) : ((((n - FH) >> 7) * 256) + 128 + ((n - FH) & 127)); }

__device__ __forceinline__ void phase_prep(const Params& P, LAS unsigned char* lds, int tid, int wave, int lane) {
    const int G = gridDim.x, gw = blockIdx.x * NWAVES + wave, NGW = G * NWAVES;
    unsigned char* ws = P.ws;
    LAS float* scr = (LAS float*)(lds + wave * 16384);
    constexpr int I_WIN = (D / 64) * (GIN / 32), I_WOUT = (D / 64) * (D / 32), I_SCIN = (D / 64) * (3 * D / 32), I_UP = (D / 64) * (FUP / 32), I_DN = (FH / 64) * (D / 32);
    constexpr int NITEMS = I_WIN + 2 * I_WOUT + I_SCIN + 2 * I_UP + 2 * I_DN;
    for (int it = gw; it < NITEMS; it += NGW) {
        int r = it;
        if (r < I_WIN) { const int nb = GIN / 32, kb = r / nb, n0 = 32 * (r % nb); transpose_item(P.in[I_GWIN], D, GIN, (bf16*)(ws + WS_WIN), 64 * kb, n0, n0, scr, lane); continue; } r -= I_WIN;
        if (r < I_WOUT) { const int nb = D / 32, kb = r / nb, n0 = 32 * (r % nb); transpose_item(P.in[I_GWOUT], D, D, (bf16*)(ws + WS_WOUT), 64 * kb, n0, n0, scr, lane); continue; } r -= I_WOUT;
        if (r < I_WOUT) { const int nb = D / 32, kb = r / nb, n0 = 32 * (r % nb); transpose_item(P.in[I_SCWOUT], D, D, (bf16*)(ws + WS_SCOUT), 64 * kb, n0, n0, scr, lane); continue; } r -= I_WOUT;
        if (r < I_SCIN) { const int nb = 3 * D / 32, kb = r / nb, n0 = 32 * (r % nb); transpose_item(P.in[I_SCWIN], D, 3 * D, (bf16*)(ws + WS_SCIN), 64 * kb, n0, n0, scr, lane); continue; } r -= I_SCIN;
        if (r < 2 * I_UP) { const int l = r / I_UP; r -= l * I_UP; const int nb = FUP / 32, kb = r / nb, n0 = 32 * (r % nb);
            transpose_item(P.in[I_FUP] + (size_t)l * D * FUP, D, FUP, (bf16*)(ws + WS_WUP) + (size_t)l * FUP * D, 64 * kb, n0, uprow(n0), scr, lane); continue; } r -= 2 * I_UP;
        { const int l = r / I_DN; r -= l * I_DN; const int nb = D / 32, kb = r / nb, n0 = 32 * (r % nb);
            transpose_item(P.in[I_FDN] + (size_t)l * FH * D, FH, D, (bf16*)(ws + WS_WDN) + (size_t)l * D * FH, 64 * kb, n0, n0, scr, lane); }
    }
    { v4u* z = (v4u*)((bf16*)(ws + WS_WIN) + (size_t)GIN * D); const int n16 = (GINP - GIN) * D * 2 / 16;
      for (int i = blockIdx.x * NTHREADS + tid; i < n16; i += G * NTHREADS) z[i] = (v4u){0u, 0u, 0u, 0u}; }
    __syncthreads();
    if ((int)blockIdx.x < 192) {
        LAS float* s = (LAS float*)lds;
        LAS float* red = s + MODROWS * D;
        for (int i = tid; i < MODROWS * D; i += NTHREADS) { const int b = i >> 10, k = i & 1023; const float cv = b < 16 ? P.in[I_C][b * D + k] : P.in[I_CCTX][k]; s[i] = silu_f(cv); }
        __syncthreads();
        float* MOD = (float*)(ws + WS_MOD);
        for (int it = blockIdx.x; it < 192; it += G) {
            const int layer = it / 96, cb = it % 96, col = cb * 64 + lane;
            const float* W = P.in[I_ADAW] + (size_t)layer * D * NMOD;
            float acc[MODROWS];
#pragma unroll
            for (int b = 0; b < MODROWS; ++b) acc[b] = 0.f;
            for (int k = wave * 128; k < wave * 128 + 128; k += 4) {
                const float w0 = W[(size_t)(k + 0) * NMOD + col], w1 = W[(size_t)(k + 1) * NMOD + col], w2 = W[(size_t)(k + 2) * NMOD + col], w3 = W[(size_t)(k + 3) * NMOD + col];
#pragma unroll
                for (int b = 0; b < MODROWS; ++b) { const f32x4 sv = *(const LAS f32x4*)(s + b * D + k); acc[b] += sv[0] * w0 + sv[1] * w1 + sv[2] * w2 + sv[3] * w3; }
            }
#pragma unroll
            for (int b = 0; b < MODROWS; ++b) red[(wave * MODROWS + b) * 64 + lane] = acc[b];
            __syncthreads();
            for (int o = tid; o < MODROWS * 64; o += NTHREADS) { const int b = o >> 6, l = o & 63; float sum = 0.f;
#pragma unroll
                for (int w = 0; w < NWAVES; ++w) sum += red[(w * MODROWS + b) * 64 + l];
                MOD[(size_t)(layer * MODROWS + b) * NMOD + cb * 64 + l] = sum + P.in[I_ADAB][layer * NMOD + cb * 64 + l]; }
            __syncthreads();
        }
    }
}

__device__ __forceinline__ void modulate_rows(const float* src, int nrows, int rows_per_b, int bfix, const float* gain, const float* mod, int shift_i, int scale_i, bf16* dst, int gw, int NGW, int lane) {
    for (int row = gw; row < nrows; row += NGW) {
        const int b = bfix >= 0 ? bfix : row / rows_per_b;
        const f32x4* xr = (const f32x4*)(src + (size_t)row * D) + lane;
        f32x4 v[4]; float ss = 0.f;
#pragma unroll
        for (int j = 0; j < 4; ++j) { v[j] = xr[64 * j]; ss += (v[j][0] * v[j][0] + v[j][1] * v[j][1]) + (v[j][2] * v[j][2] + v[j][3] * v[j][3]); }
        const float rstd = 1.0f / sqrtf(wave_sum(ss) * (1.0f / D) + EPS);
        const float* sh = mod + (size_t)b * NMOD + shift_i * D; const float* sc = mod + (size_t)b * NMOD + scale_i * D;
        v2u* o8 = (v2u*)(dst + (size_t)row * D) + lane;
#pragma unroll
        for (int j = 0; j < 4; ++j) { const int idx = 4 * lane + 256 * j; const f32x4 g = *(const f32x4*)(gain + idx), s4 = *(const f32x4*)(sh + idx), c4 = *(const f32x4*)(sc + idx);
            const f32x4 y = ((v[j] * rstd) * g) * (c4 + 1.0f) + s4; v2u w; w.x = pk2(y[0], y[1]); w.y = pk2(y[2], y[3]); o8[64 * j] = w; }
    }
}
__device__ __forceinline__ void final_norm_rows(float* h, const float* gain, int gw, int NGW, int lane) {
    for (int row = gw; row < NTOK; row += NGW) {
        f32x4* xr = (f32x4*)(h + (size_t)row * D) + lane;
        f32x4 v[4]; float ss = 0.f;
#pragma unroll
        for (int j = 0; j < 4; ++j) { v[j] = xr[64 * j]; ss += (v[j][0] * v[j][0] + v[j][1] * v[j][1]) + (v[j][2] * v[j][2] + v[j][3] * v[j][3]); }
        const float rstd = 1.0f / sqrtf(wave_sum(ss) * (1.0f / D) + EPS);
#pragma unroll
        for (int j = 0; j < 4; ++j) { const f32x4 g = *(const f32x4*)(gain + 4 * lane + 256 * j); xr[64 * j] = (v[j] * rstd) * g; }
    }
}

__device__ __forceinline__ void phase_scan_naive(const Params& P, LAS unsigned char* lds, int tid) {
    const int half = tid >> 8, t8 = tid & 255;
    LAS float* buf = (LAS float*)lds + half * 768;
    const bf16* PROJ = (const bf16*)(P.ws + WS_PROJ); const float* ALOW = (const float*)(P.ws + WS_ALOW);
    for (int it0 = blockIdx.x * 2; it0 < BATCH * 4 * 2; it0 += gridDim.x * 2) {
        const int item = it0 + half, b = item >> 3, h = (item >> 1) & 3, dir = item & 1;
        bf16* O = (bf16*)(P.ws + (dir ? WS_OB : WS_OF));
        float S[HK];
#pragma unroll
        for (int c = 0; c < HK; ++c) S[c] = 0.f;
        float w2[RANK], ba = 0.f;
#pragma unroll
        for (int r = 0; r < RANK; ++r) w2[r] = 0.f;
        if (t8 < HK) {
#pragma unroll
            for (int r = 0; r < RANK; ++r) w2[r] = P.in[I_GWA2][(dir * RANK + r) * KD + h * HK + t8];
            ba = P.in[I_GBA][dir * KD + h * HK + t8]; }
        for (int step = 0; step < CTXL + SEQ; ++step) {
            const bool isctx = step < CTXL; const int idx = isctx ? step : step - CTXL, n = isctx ? CTXL : SEQ, pos = dir ? n - 1 - idx : idx;
            const size_t row = isctx ? (size_t)NTOK + b * CTXL + pos : (size_t)b * SEQ + pos;
            LAS float* cur = buf + (step & 1) * 384;
            const bf16* pr = PROJ + row * GINP;
            if (t8 < HK) {
                const float q = bf2f(pr[h * HK + t8]) * 0.08838834764831845f, k = bf2f(pr[KD + h * HK + t8]);
                const float* al = ALOW + row * 32 + dir * RANK; float z = ba;
#pragma unroll
                for (int r = 0; r < RANK; ++r) z += al[r] * w2[r];
                const float ls = fminf(z, 0.f) - log1pf(expf(-fabsf(z)));
                cur[t8] = q; cur[128 + t8] = k; cur[256 + t8] = expf(ls * (1.0f / 16.0f));
            }
            const float v = bf2f(pr[2 * KD + h * HV + t8]);
            __syncthreads();
            float o = 0.f;
#pragma unroll
            for (int c = 0; c < HK; c += 4) { const f32x4 q4 = *(const LAS f32x4*)(cur + c), k4 = *(const LAS f32x4*)(cur + 128 + c), a4 = *(const LAS f32x4*)(cur + 256 + c);
#pragma unroll
                for (int j = 0; j < 4; ++j) { S[c + j] = a4[j] * S[c + j] + k4[j] * v; o += q4[j] * S[c + j]; } }
            if (!isctx) O[row * VD + h * HV + t8] = (bf16)f2bf(o);
        }
    }
}

__device__ __forceinline__ void phase_gate(const Params& P, int gw, int NGW, int lane) {
    const bf16* OF = (const bf16*)(P.ws + WS_OF); const bf16* OB = (const bf16*)(P.ws + WS_OB); const bf16* PROJ = (const bf16*)(P.ws + WS_PROJ); bf16* A = (bf16*)(P.ws + WS_HN);
    const float* hg = P.in[I_GHN] + ((16 * lane) & 255);
    float hgv[16];
#pragma unroll
    for (int i = 0; i < 16; ++i) hgv[i] = hg[i];
    for (int row = gw; row < NTOK; row += NGW) {
        const v4u* pf = (const v4u*)(OF + (size_t)row * VD + 16 * lane); const v4u* pb = (const v4u*)(OB + (size_t)row * VD + 16 * lane); const v4u* pg = (const v4u*)(PROJ + (size_t)row * GINP + 2 * KD + VD + 16 * lane);
        float o[16], t[8], g[16];
        unpack8(pf[0], t);
#pragma unroll
        for (int i = 0; i < 8; ++i) o[i] = t[i];
        unpack8(pf[1], t);
#pragma unroll
        for (int i = 0; i < 8; ++i) o[8 + i] = t[i];
        unpack8(pb[0], t);
#pragma unroll
        for (int i = 0; i < 8; ++i) o[i] += t[i];
        unpack8(pb[1], t);
#pragma unroll
        for (int i = 0; i < 8; ++i) o[8 + i] += t[i];
        unpack8(pg[0], t);
#pragma unroll
        for (int i = 0; i < 8; ++i) g[i] = t[i];
        unpack8(pg[1], t);
#pragma unroll
        for (int i = 0; i < 8; ++i) g[8 + i] = t[i];
        float ss = 0.f;
#pragma unroll
        for (int i = 0; i < 16; ++i) ss += o[i] * o[i];
        ss += __shfl_xor(ss, 1); ss += __shfl_xor(ss, 2); ss += __shfl_xor(ss, 4); ss += __shfl_xor(ss, 8);
        const float rstd = 1.0f / sqrtf(ss * (1.0f / HV) + EPS);
        float r0[8], r1[8];
#pragma unroll
        for (int i = 0; i < 8; ++i) { r0[i] = ((o[i] * rstd) * hgv[i]) * silu_f(g[i]); r1[i] = ((o[8 + i] * rstd) * hgv[8 + i]) * silu_f(g[8 + i]); }
        v4u* pa = (v4u*)(A + (size_t)row * D + 16 * lane); pa[0] = pack8(r0); pa[1] = pack8(r1);
    }
}

__device__ __forceinline__ void phase_convgate(const Params& P, int layer, int half, int gtid, int NT) {
    const bf16* U = (const bf16*)(P.ws + WS_U); bf16* ACT = (bf16*)(P.ws + WS_ACT);
    const float* cw = P.in[I_FCW] + (size_t)layer * 3 * FUP; const float* cb = P.in[I_FCB] + (size_t)layer * FUP;
    const int NITEM = NTOK * 160;
    for (int it = gtid; it < NITEM; it += NT) {
        const int t = it / 160, cg8 = it % 160, pnl = cg8 >> 4, j = (cg8 & 15) * 8, ch = (half * 10 + pnl) * 128 + j;
        const int gr = (t & (SEQ - 1)) >> 6;
        const bf16* ua = U + (size_t)t * FH + pnl * 256 + j; const bf16* ug = ua + 128;
        float a[8], g[8], tmp[8];
#pragma unroll
        for (int i = 0; i < 8; ++i) { a[i] = cb[ch + i]; g[i] = cb[FH + ch + i]; }
#pragma unroll
        for (int tap = 0; tap < 3; ++tap) {
            const int rr = gr + tap - 1; if (rr < 0 || rr > 31) continue;
            const long off = (long)(tap - 1) * 64 * FH;
            unpack8(*(const v4u*)(ua + off), tmp);
#pragma unroll
            for (int i = 0; i < 8; ++i) a[i] += tmp[i] * cw[tap * FUP + ch + i];
            unpack8(*(const v4u*)(ug + off), tmp);
#pragma unroll
            for (int i = 0; i < 8; ++i) g[i] += tmp[i] * cw[tap * FUP + FH + ch + i];
        }
        float r[8];
#pragma unroll
        for (int i = 0; i < 8; ++i) r[i] = a[i] * silu_f(g[i]);
        *(v4u*)(ACT + (size_t)t * FH + ch) = pack8(r);
    }
}
__device__ __forceinline__ void phase_scconv(const Params& P, int gtid, int NT) {
    const bf16* BCV = (const bf16*)(P.ws + WS_BCV); bf16* A = (bf16*)(P.ws + WS_HN);
    const float* cw = P.in[I_SCCW];
    const int NITEM = NTOK * 128;
    for (int it = gtid; it < NITEM; it += NT) {
        const int t = it >> 7, ch = (it & 127) * 8, col = t & 63;
        const bf16* p = BCV + (size_t)t * (3 * D) + ch;
        float acc[8], bgv[8], c8[8], v8[8];
#pragma unroll
        for (int i = 0; i < 8; ++i) acc[i] = 0.f;
#pragma unroll
        for (int tap = 0; tap < 3; ++tap) {
            const int cc = col + tap - 1; if (cc < 0 || cc > 63) continue;
            const long off = (long)(tap - 1) * 3 * D;
            unpack8(*(const v4u*)(p + off + D), c8); unpack8(*(const v4u*)(p + off + 2 * D), v8);
#pragma unroll
            for (int i = 0; i < 8; ++i) acc[i] += (c8[i] * v8[i]) * cw[tap * D + ch + i];
        }
        unpack8(*(const v4u*)p, bgv);
        float r[8];
#pragma unroll
        for (int i = 0; i < 8; ++i) r[i] = bgv[i] * acc[i];
        *(v4u*)(A + (size_t)t * D + ch) = pack8(r);
    }
}


namespace scn {
typedef short bf16x8 __attribute__((ext_vector_type(8)));
typedef short s16x4 __attribute__((ext_vector_type(4)));
typedef float f32x16 __attribute__((ext_vector_type(16)));
typedef float f32x2 __attribute__((ext_vector_type(2)));
typedef __bf16 bf16x2 __attribute__((ext_vector_type(2)));
constexpr int OFF_Q = 0, OFF_K = 16384, OFF_V = 32768, OFF_AL = 49152, BUF = 53248;
constexpr int OFF_P = 2 * BUF, OFF_TOT = OFF_P + 8192, OFF_EL = OFF_TOT + 4096, OFF_X = OFF_EL + 512, LDS_END = OFF_X + 32768;
__device__ __forceinline__ unsigned offb(unsigned row, unsigned ch) { return 256u * row + 16u * (ch ^ (((row & 3u) << 2) | ((row >> 2) & 3u))); }
__device__ __forceinline__ unsigned offp(unsigned i, unsigned ch) { return 128u * i + 16u * (ch ^ ((i >> 1) & 7u)); }
__device__ __forceinline__ unsigned cvtpk(float lo, float hi) { const f32x2 v = {lo, hi}; return __builtin_bit_cast(unsigned, __builtin_convertvector(v, bf16x2)); }
__device__ __forceinline__ s16x4 trrd(LAS unsigned char* p) { return __builtin_bit_cast(s16x4, __builtin_amdgcn_ds_read_tr16_b64_v4i16((LAS s16x4*)p)); }
__device__ __forceinline__ bf16x8 trfrag(LAS unsigned char* img, int lane, int c, int ks) {
    const unsigned h = lane >> 5, blk = (lane >> 4) & 1, q = (lane & 15) >> 2, p = lane & 3;
    const s16x4 lo = trrd(img + offb(16 * ks + 8 * h + q, 4 * c + 2 * blk + (p >> 1)) + 8 * (p & 1));
    const s16x4 hi = trrd(img + offb(16 * ks + 8 * h + 4 + q, 4 * c + 2 * blk + (p >> 1)) + 8 * (p & 1));
    return __builtin_shufflevector(lo, hi, 0, 1, 2, 3, 4, 5, 6, 7);
}
__device__ __forceinline__ bf16x8 pack_step(const f32x16& x, int s) {
    v4u p; p.x = cvtpk(x[8 * s], x[8 * s + 1]); p.y = cvtpk(x[8 * s + 2], x[8 * s + 3]); p.z = cvtpk(x[8 * s + 4], x[8 * s + 5]); p.w = cvtpk(x[8 * s + 6], x[8 * s + 7]);
    return __builtin_bit_cast(bf16x8, p);
}
#define MFMA32(a, b, c) __builtin_amdgcn_mfma_f32_32x32x16_bf16((a), (b), (c), 0, 0, 0)
#define MFMA16(a, b, c) __builtin_amdgcn_mfma_f32_16x16x32_bf16((a), (b), (c), 0, 0, 0)

__device__ __forceinline__ void phase_scan(const Params& P, LAS unsigned char* lds, int tid, int wave, int lane) {
    const bf16* PROJ = (const bf16*)(P.ws + WS_PROJ); const float* ALOW = (const float*)(P.ws + WS_ALOW);
    const int ch = wave >> 2, dq = wave & 3;
    for (int item = blockIdx.x; item < BATCH * 4 * 2 * 2; item += gridDim.x) {
        const int b = item >> 4, h = (item >> 2) & 3, dir = (item >> 1) & 1, dvh = item & 1;
        bf16* O = (bf16*)(P.ws + (dir ? WS_OB : WS_OF));
        float w2a[RANK], w2b[RANK];
#pragma unroll
        for (int rr = 0; rr < RANK; ++rr) { const f32x2 w = *(const f32x2*)(P.in[I_GWA2] + (size_t)(dir * RANK + rr) * KD + h * HK + 2 * lane); w2a[rr] = w[0]; w2b[rr] = w[1]; }
        const f32x2 bav = *(const f32x2*)(P.in[I_GBA] + dir * KD + h * HK + 2 * lane);
        f32x16 S[2];
#pragma unroll
        for (int i = 0; i < 16; ++i) { S[0][i] = 0.f; S[1][i] = 0.f; }
        v4u rq[2], rk[2], rv[2], ra;
#define SCN_ROW0(s) ((s) < 4 ? (size_t)NTOK + (size_t)b * CTXL + 64 * (dir ? 3 - (s) : (s)) : (size_t)b * SEQ + 64 * (dir ? 31 - ((s) - 4) : ((s) - 4)))
#define SCN_LOAD(s) do { const size_t row0_ = SCN_ROW0(s); _Pragma("unroll") for (int i_ = 0; i_ < 2; ++i_) { const int cx_ = tid + 512 * i_, rw_ = cx_ >> 4, c16_ = cx_ & 15; \
            const bf16* pr_ = PROJ + (row0_ + rw_) * GINP + 8 * c16_; rq[i_] = *(const v4u*)(pr_ + h * HK); rk[i_] = *(const v4u*)(pr_ + KD + h * HK); rv[i_] = *(const v4u*)(pr_ + 2 * KD + h * HV + dvh * 128); } \
            if (tid < 256) ra = *(const v4u*)(ALOW + (row0_ + (tid >> 2)) * 32 + dir * RANK + 4 * (tid & 3)); } while (0)
#define SCN_STORE(bo) do { _Pragma("unroll") for (int i_ = 0; i_ < 2; ++i_) { const int cx_ = tid + 512 * i_, rw_ = cx_ >> 4, c16_ = cx_ & 15; const unsigned o_ = offb(rw_, c16_); \
            *(LAS v4u*)(lds + (bo) + OFF_Q + o_) = rq[i_]; *(LAS v4u*)(lds + (bo) + OFF_K + o_) = rk[i_]; *(LAS v4u*)(lds + (bo) + OFF_V + o_) = rv[i_]; } \
            if (tid < 256) *(LAS v4u*)(lds + (bo) + OFF_AL + tid * 16) = ra; } while (0)
        SCN_LOAD(0); SCN_STORE(0);
        __syncthreads();
        for (int s = 0; s < 36; ++s) {
            const int bo = (s & 1) * BUF; const bool isctx = s < 4;
            LAS unsigned char* Qi = lds + bo + OFF_Q; LAS unsigned char* Ki = lds + bo + OFF_K; LAS unsigned char* Vi = lds + bo + OFF_V;
            const LAS float* AL = (const LAS float*)(lds + bo + OFF_AL);
            LAS float* TOT = (LAS float*)(lds + OFF_TOT); LAS float* EL = (LAS float*)(lds + OFF_EL);
            int lg = lane; asm volatile("" : "+v"(lg));
            float P0[8], P1[8]; float run0 = 0.f, run1 = 0.f;
#pragma unroll
            for (int t = 0; t < 8; ++t) {
                const int j = 8 * wave + t; float z0 = bav[0], z1 = bav[1];
#pragma unroll
                for (int q4 = 0; q4 < 4; ++q4) { const f32x4 a = *(const LAS f32x4*)(AL + j * 16 + 4 * q4);
#pragma unroll
                    for (int e = 0; e < 4; ++e) { z0 += a[e] * w2a[4 * q4 + e]; z1 += a[e] * w2b[4 * q4 + e]; } }
                const float l0 = (fminf(z0, 0.f) - log1pf(expf(-fabsf(z0)))) * 0.0625f, l1 = (fminf(z1, 0.f) - log1pf(expf(-fabsf(z1)))) * 0.0625f;
                run0 += l0; run1 += l1; P0[t] = run0; P1[t] = run1;
            }
            *(LAS f32x2*)(TOT + wave * 128 + 2 * lg) = (f32x2){run0, run1};
            __syncthreads();
            float off0 = 0.f, off1 = 0.f, T0 = 0.f, T1 = 0.f;
#pragma unroll
            for (int g = 0; g < 8; ++g) { const f32x2 tv = *(const LAS f32x2*)(TOT + g * 128 + 2 * lg); if (g < wave) { off0 += tv[0]; off1 += tv[1]; } T0 += tv[0]; T1 += tv[1]; }
#pragma unroll
            for (int t = 0; t < 8; ++t) {
                const int j = 8 * wave + t;
                const float pre0 = off0 + P0[t], pre1 = off1 + P1[t];
                const float l0 = P0[t] - (t ? P0[t > 0 ? t - 1 : 0] : 0.f), l1 = P1[t] - (t ? P1[t > 0 ? t - 1 : 0] : 0.f);
                const float bc0 = dir ? (T0 - pre0 + l0) : pre0, bc1 = dir ? (T1 - pre1 + l1) : pre1;
                const float e0 = __expf(-bc0), e1 = __expf(-bc1), r0 = __expf(bc0) * 0.08838834764831845f, r1 = __expf(bc1) * 0.08838834764831845f;
                const unsigned ao = offb(j, lg >> 2) + 4 * (lg & 3);
                const unsigned qw = *(const LAS unsigned*)(Qi + ao), kw = *(const LAS unsigned*)(Ki + ao);
                *(LAS unsigned*)(Qi + ao) = cvtpk(bflo(qw) * r0, bfhi(qw) * r1);
                *(LAS unsigned*)(Ki + ao) = cvtpk(bflo(kw) * e0, bfhi(kw) * e1);
            }
            if (wave == 0) *(LAS f32x2*)(EL + 2 * lg) = (f32x2){__expf(T0), __expf(T1)};
            __syncthreads();
            if (!isctx) {
                int la_ = lane; asm volatile("" : "+v"(la_));
                const int i16 = wave & 3, jh = wave >> 2, fr = la_ & 15, fq = la_ >> 4;
                f32x4 at[2] = {{0.f, 0.f, 0.f, 0.f}, {0.f, 0.f, 0.f, 0.f}};
#pragma unroll
                for (int ks = 0; ks < 4; ++ks) {
                    const bf16x8 qf = *(const LAS bf16x8*)(Qi + offb(16 * i16 + fr, 4 * ks + fq));
#pragma unroll
                    for (int jj = 0; jj < 2; ++jj) { const bf16x8 kf = *(const LAS bf16x8*)(Ki + offb(16 * (2 * jh + jj) + fr, 4 * ks + fq)); at[jj] = MFMA16(kf, qf, at[jj]); }
                }
                const int ig = 16 * i16 + fr;
#pragma unroll
                for (int jj = 0; jj < 2; ++jj) { const int j0 = 16 * (2 * jh + jj) + 4 * fq; float m[4];
#pragma unroll
                    for (int e = 0; e < 4; ++e) { const int jg = j0 + e; const bool keep = dir ? (jg >= ig) : (jg <= ig); m[e] = keep ? at[jj][e] : 0.f; }
                    v2u w; w.x = cvtpk(m[0], m[1]); w.y = cvtpk(m[2], m[3]);
                    *(LAS v2u*)(lds + OFF_P + offp(ig, j0 >> 3) + 2 * (j0 & 7)) = w; }
            }
            __syncthreads();
            if (s + 1 < 36) SCN_LOAD(s + 1);
            int lm = lane; asm volatile("" : "+v"(lm));
            const int r = lm & 31, hh = lm >> 5;
            f32x16 o[2];
#pragma unroll
            for (int i = 0; i < 16; ++i) { o[0][i] = 0.f; o[1][i] = 0.f; }
            bf16x8 vf[4];
#pragma unroll
            for (int ks = 0; ks < 4; ++ks) vf[ks] = trfrag(Vi, lm, dq, ks);
            if (!isctx) {
                bf16x8 sb[2][2];
#pragma unroll
                for (int c2 = 0; c2 < 2; ++c2)
#pragma unroll
                    for (int st = 0; st < 2; ++st) sb[c2][st] = pack_step(S[c2], st);
#pragma unroll
                for (int it = 0; it < 2; ++it) {
#pragma unroll
                    for (int c2 = 0; c2 < 2; ++c2)
#pragma unroll
                        for (int st = 0; st < 2; ++st) { const unsigned cch = 8 * ch + 4 * c2 + 2 * st;
                            const s16x4 lo = *(const LAS s16x4*)(Qi + offb(32 * it + r, cch) + 8 * hh), hi = *(const LAS s16x4*)(Qi + offb(32 * it + r, cch + 1) + 8 * hh);
                            o[it] = MFMA32(__builtin_shufflevector(lo, hi, 0, 1, 2, 3, 4, 5, 6, 7), sb[c2][st], o[it]); }
#pragma unroll
                    for (int k2 = 0; k2 < 2; ++k2) { const int ks = 2 * ch + k2; const bf16x8 pa = *(const LAS bf16x8*)(lds + OFF_P + offp(32 * it + r, 2 * ks + hh)); o[it] = MFMA32(pa, ch ? (k2 ? vf[3] : vf[2]) : (k2 ? vf[1] : vf[0]), o[it]); }
                }
            }
#pragma unroll
            for (int c2 = 0; c2 < 2; ++c2)
#pragma unroll
                for (int ks = 0; ks < 4; ++ks) S[c2] = MFMA32(trfrag(Ki, lm, 2 * ch + c2, ks), vf[ks], S[c2]);
#pragma unroll
            for (int c2 = 0; c2 < 2; ++c2)
#pragma unroll
                for (int g = 0; g < 4; ++g) { const f32x4 ev = *(const LAS f32x4*)(EL + 64 * ch + 32 * c2 + 8 * g + 4 * hh);
#pragma unroll
                    for (int e = 0; e < 4; ++e) S[c2][4 * g + e] *= ev[e]; }
            if (!isctx) {
                LAS float* X = (LAS float*)(lds + OFF_X) + wave * 1024 + lm;
#pragma unroll
                for (int i = 0; i < 16; ++i) X[64 * i] = ch ? o[0][i] : o[1][i];
            }
            __syncthreads();
            if (!isctx) {
                const LAS float* X = (const LAS float*)(lds + OFF_X) + (wave ^ 4) * 1024 + lm;
                const size_t row0 = SCN_ROW0(s);
                bf16* op = O + (row0 + 32 * ch) * VD + h * HV + dvh * 128 + 32 * dq + r;
#pragma unroll
                for (int i = 0; i < 16; ++i) { const float v = (ch ? o[1][i] : o[0][i]) + X[64 * i]; op[(size_t)((i & 3) + 8 * (i >> 2) + 4 * hh) * VD] = (bf16)f2bf(v); }
            }
            if (s + 1 < 36) SCN_STORE(BUF - bo);
            __syncthreads();
        }
#undef SCN_ROW0
#undef SCN_LOAD
#undef SCN_STORE
    }
}
#undef MFMA32
#undef MFMA16
}

enum { PH_PREP = 0, PH_MOD0, PH_GIN, PH_SCAN, PH_GATE, PH_GOUT, PH_FFN0  , PH_MOD1 = PH_FFN0 + 6, PH_SCIN, PH_SCCONV, PH_SCOUT, PH_FFN1, PH_FINAL = PH_FFN1 + 6, N_PHASES };

#define IN(k) (lo <= (k) && (k) < hi)
#define SEAM(k) do { if (IN(k) && IN((k) + 1)) { __syncthreads(); cg::this_grid().sync(); } } while (0)

__device__ __forceinline__ void ffn_block(const Params& P, LAS unsigned char* lds, int layer, int k0, int lo, int hi) {
    const int tid = threadIdx.x, lane = tid & 63, wave = __builtin_amdgcn_readfirstlane(tid >> 6);
    const int G = gridDim.x, gw = blockIdx.x * NWAVES + wave, NGW = G * NWAVES, gtid = blockIdx.x * NTHREADS + tid, NT = G * NTHREADS;
    unsigned char* ws = P.ws;
    const float* MODL = (const float*)(ws + WS_MOD) + (size_t)layer * MODROWS * NMOD;
    if (IN(k0)) modulate_rows(P.out, NTOK, SEQ, -1, P.in[I_NFFN] + layer * D, MODL, 3, 4, (bf16*)(ws + WS_HN), gw, NGW, lane);
    SEAM(k0);
#pragma unroll
    for (int half = 0; half < 2; ++half) {
        if (IN(k0 + 1 + 2 * half)) {
            pg8::Gemm g{(const bf16*)(ws + WS_HN), (const bf16*)(ws + WS_WUP) + (size_t)layer * FUP * D + (size_t)half * FH * D, NTOK, FH, D};
            pg8::StaticOrder S; S.init(g.M, g.N, G, (int)blockIdx.x);
            pg8::EpiBf16 E{(bf16*)(ws + WS_U), FH};
            pg8::gemm_phase<pg8::EpiBf16, pg8::StaticOrder, true, true>(lds, g, S, E);
        }
        SEAM(k0 + 1 + 2 * half);
        if (IN(k0 + 2 + 2 * half)) phase_convgate(P, layer, half, gtid, NT);
        SEAM(k0 + 2 + 2 * half);
    }
    if (IN(k0 + 5)) {
        pg8::Gemm g{(const bf16*)(ws + WS_ACT), (const bf16*)(ws + WS_WDN) + (size_t)layer * D * FH, NTOK, D, FH};
        pg8::StaticOrder S; S.init(g.M, g.N, G, (int)blockIdx.x);
        pg8::EpiResid E{P.out, P.out, MODL + 5 * D, NMOD, SEQ, D};
        pg8::gemm_phase<pg8::EpiResid, pg8::StaticOrder, true, true>(lds, g, S, E);
    }
    SEAM(k0 + 5);
}

__global__ void __launch_bounds__(NTHREADS, 2) fwd_kernel(Params P) {
    extern __shared__ __attribute__((aligned(16))) unsigned char lds_raw[];
    LAS unsigned char* lds = (LAS unsigned char*)lds_raw;
    const int tid = threadIdx.x, lane = tid & 63, wave = __builtin_amdgcn_readfirstlane(tid >> 6);
    const int G = gridDim.x, gw = blockIdx.x * NWAVES + wave, NGW = G * NWAVES, gtid = blockIdx.x * NTHREADS + tid, NT = G * NTHREADS;
    unsigned char* ws = P.ws;
    const int lo = P.ph_lo, hi = P.ph_hi;
    const float* MOD = (const float*)(ws + WS_MOD);
    bf16* HN = (bf16*)(ws + WS_HN);

    if (IN(PH_PREP)) phase_prep(P, lds, tid, wave, lane);
    SEAM(PH_PREP);
    if (IN(PH_MOD0)) {
        modulate_rows(P.in[I_X], NTOK, SEQ, -1, P.in[I_NMIX], MOD, 0, 1, HN, gw, NGW, lane);
        modulate_rows(P.in[I_CTX], NCTX, CTXL, 16, P.in[I_NMIX], MOD, 0, 1, HN + (size_t)NTOK * D, gw, NGW, lane);
    }
    SEAM(PH_MOD0);
    if (IN(PH_GIN)) {
        pg8::Gemm g{HN, (const bf16*)(ws + WS_WIN), MROWS, GINP, D};
        pg8::StaticOrder S; S.init(g.M, g.N, G, (int)blockIdx.x);
        pg8::EpiProj E{(bf16*)(ws + WS_PROJ), GINP, (float*)(ws + WS_ALOW), 12};
        pg8::gemm_phase<pg8::EpiProj, pg8::StaticOrder, true, true>(lds, g, S, E);
    }
    SEAM(PH_GIN);
    #ifdef SCAN_NAIVE
    if (IN(PH_SCAN)) phase_scan_naive(P, lds, tid);
#else
    if (IN(PH_SCAN)) scn::phase_scan(P, lds, tid, wave, lane);
#endif
    SEAM(PH_SCAN);
    if (IN(PH_GATE)) phase_gate(P, gw, NGW, lane);
    SEAM(PH_GATE);
    if (IN(PH_GOUT)) {
        pg8::Gemm g{HN, (const bf16*)(ws + WS_WOUT), NTOK, D, D};
        pg8::StaticOrder S; S.init(g.M, g.N, G, (int)blockIdx.x);
        pg8::EpiResid E{P.in[I_X], P.out, MOD + 2 * D, NMOD, SEQ, D};
        pg8::gemm_phase<pg8::EpiResid, pg8::StaticOrder, true, true>(lds, g, S, E);
    }
    SEAM(PH_GOUT);
    ffn_block(P, lds, 0, PH_FFN0, lo, hi);
    if (IN(PH_MOD1)) modulate_rows(P.out, NTOK, SEQ, -1, P.in[I_NMIX] + D, MOD + (size_t)MODROWS * NMOD, 0, 1, HN, gw, NGW, lane);
    SEAM(PH_MOD1);
    if (IN(PH_SCIN)) {
        pg8::Gemm g{HN, (const bf16*)(ws + WS_SCIN), NTOK, 3 * D, D};
        pg8::StaticOrder S; S.init(g.M, g.N, G, (int)blockIdx.x);
        pg8::EpiBf16 E{(bf16*)(ws + WS_BCV), 3 * D};
        pg8::gemm_phase<pg8::EpiBf16, pg8::StaticOrder, true, true>(lds, g, S, E);
    }
    SEAM(PH_SCIN);
    if (IN(PH_SCCONV)) phase_scconv(P, gtid, NT);
    SEAM(PH_SCCONV);
    if (IN(PH_SCOUT)) {
        pg8::Gemm g{HN, (const bf16*)(ws + WS_SCOUT), NTOK, D, D};
        pg8::StaticOrder S; S.init(g.M, g.N, G, (int)blockIdx.x);
        pg8::EpiResid E{P.out, P.out, MOD + (size_t)MODROWS * NMOD + 2 * D, NMOD, SEQ, D};
        pg8::gemm_phase<pg8::EpiResid, pg8::StaticOrder, true, true>(lds, g, S, E);
    }
    SEAM(PH_SCOUT);
    ffn_block(P, lds, 1, PH_FFN1, lo, hi);
    if (IN(PH_FINAL)) final_norm_rows(P.out, P.in[I_FINAL], gw, NGW, lane);
}
#undef IN
#undef SEAM

#ifndef MK_ONE_LAUNCH
#define MK_ONE_LAUNCH 1
#endif
extern "C" void kernel_launch(void* const* d_in, const int* in_sizes, int n_in, void* d_out, int out_size, void* d_ws, size_t ws_size, hipStream_t stream) {
    static int grid = 0;
    if (grid == 0) {
        if (n_in != N_IN || out_size != NTOK * D || ws_size < WS_END) { fprintf(stderr, "kernel_launch: unexpected shapes (n_in %d out %d ws %zu)\n", n_in, out_size, ws_size); grid = -1; return; }
        int dev = 0, cus = 0, per_cu = 0;
        if (hipGetDevice(&dev) != hipSuccess || hipDeviceGetAttribute(&cus, hipDeviceAttributeMultiprocessorCount, dev) != hipSuccess) { grid = -1; return; }
        if (hipFuncSetAttribute((const void*)fwd_kernel, hipFuncAttributeMaxDynamicSharedMemorySize, LDS_BYTES) != hipSuccess) { fprintf(stderr, "kernel_launch: hipFuncSetAttribute failed\n"); grid = -1; return; }
        if (hipOccupancyMaxActiveBlocksPerMultiprocessor(&per_cu, (const void*)fwd_kernel, NTHREADS, LDS_BYTES) != hipSuccess || per_cu < 1) { fprintf(stderr, "kernel_launch: occupancy query says %d\n", per_cu); per_cu = 1; }
        (void)hipGetLastError();
        grid = cus;
    }
    if (grid < 0) return;
    (void)hipMemsetAsync((char*)d_ws + WS_CTL, 0, CTL_ZERO_BYTES, stream);
    Params p{};
    for (int i = 0; i < N_IN; ++i) p.in[i] = (const float*)d_in[i];
    p.out = (float*)d_out; p.ws = (unsigned char*)d_ws;
#if MK_ONE_LAUNCH
    p.ph_lo = 0; p.ph_hi = N_PHASES;
    void* args[] = {&p};
    hipError_t e = hipLaunchCooperativeKernel((const void*)fwd_kernel, dim3(grid), dim3(NTHREADS), args, LDS_BYTES, stream);
    if (e != hipSuccess) fprintf(stderr, "cooperative launch failed: %s (grid %d)\n", hipGetErrorString(e), grid);
#else
    for (int ph = 0; ph < N_PHASES; ++ph) { p.ph_lo = ph; p.ph_hi = ph + 1; hipLaunchKernelGGL(fwd_kernel, dim3(grid), dim3(NTHREADS), LDS_BYTES, stream, p); }
#endif
}
```

```cpp
#include <hip/hip_runtime.h>
#include <hip/hip_cooperative_groups.h>
#include <cstdio>
#include <cstdint>
namespace cg = cooperative_groups;
namespace pg8 {
#define PG8_LAS __attribute__((address_space(3)))
typedef unsigned short bf16_t;
typedef short bf16x8 __attribute__((ext_vector_type(8)));
typedef float f32x4 __attribute__((ext_vector_type(4)));
typedef unsigned u32x4 __attribute__((ext_vector_type(4)));
constexpr int BM = 256, BK = 64, HALF = 128, HTB = HALF * BK * 2  , STAGE_BYTES = 8 * HTB, NXCD = 8, WGM = 8;

__host__ __device__ __forceinline__ int lds_byte(int r, int c) { const int st = (r >> 4) * 2 + (c >> 5), rr = r & 15, cc = c & 31, ob = rr * 64 + cc * 2; return st * 1024 + (ob ^ (((ob >> 9) & 1) << 5)); }
__host__ __device__ __forceinline__ void stage_rc(int b, int& R, int& C) { const int st = b / 1024, sb = b % 1024, swz = sb ^ (((sb >> 9) & 1) << 5); R = (st >> 1) * 16 + swz / 64; C = (st & 1) * 32 + (swz % 64) / 2; }
__host__ __device__ __forceinline__ int perm32(int rho) { const int n = rho >> 4, i = rho & 15; return 8 * (i >> 2) + 4 * n + (i & 3); }

struct Unit { int pm, pn; };
struct Gemm { const bf16_t* A; const bf16_t* Bt; int M, N, K; };

struct StaticOrder {
    int nM, nN, nwg, G, c;
    __host__ __device__ void init(int M, int N, int G_, int c_) { nM = M / BM; nN = N / BM; nwg = nM * nN; G = G_; c = c_; }
    __host__ __device__ bool next(int i, Unit& u) const {
        const long L = (long)i * G + c; if (L >= nwg) return false;
        int wgid = (int)L; { const int q = nwg / NXCD, r = nwg % NXCD, xcd = wgid % NXCD, off = wgid / NXCD; wgid = (xcd < r ? xcd * (q + 1) : r * (q + 1) + (xcd - r) * q) + off; }
        const int nig = WGM * nN, gid = wgid / nig, fm = gid * WGM, gsz = (nM - fm) < WGM ? (nM - fm) : WGM;
        u.pm = fm + ((wgid % nig) % gsz); u.pn = (wgid % nig) / gsz; return true;
    }
    __device__ __forceinline__ void a_ready(const Unit&) const {}
    __device__ __forceinline__ void done(const Unit&) const {}
};


__device__ __forceinline__ unsigned cvt_pk_bf16(float lo, float hi) { unsigned r; asm volatile("v_cvt_pk_bf16_f32 %0, %1, %2" : "=v"(r) : "v"(lo), "v"(hi)); return r; }

struct EpiBf16 {
    static constexpr bool PERM = true, AFTER_DRAIN = false;
    bf16_t* O; int ldc;
    __device__ __forceinline__ void operator()(const f32x4 (&acc)[2][2][4][2], const Unit& u, int wr, int wc, int fr, int fq) const {
        const int row0 = u.pm * BM + wr * 64 + fr; const int col0 = u.pn * BM + wc * 32 + 8 * fq;
#pragma unroll
        for (int ai = 0; ai < 2; ++ai)
#pragma unroll
            for (int m = 0; m < 4; ++m) { bf16_t* rowp = O + (size_t)(row0 + ai * HALF + m * 16) * ldc + col0;
#pragma unroll
                for (int bj = 0; bj < 2; ++bj) { const f32x4 v0 = acc[ai][bj][m][0], v1 = acc[ai][bj][m][1];
                    u32x4 w; w.x = cvt_pk_bf16(v0[0], v0[1]); w.y = cvt_pk_bf16(v0[2], v0[3]); w.z = cvt_pk_bf16(v1[0], v1[1]); w.w = cvt_pk_bf16(v1[2], v1[3]);
                    *(u32x4*)(rowp + bj * HALF) = w; } }
    }
};
struct EpiProj {
    static constexpr bool PERM = true, AFTER_DRAIN = false;
    bf16_t* O; int ldc; float* alow; int pn_low;
    __device__ __forceinline__ void operator()(const f32x4 (&acc)[2][2][4][2], const Unit& u, int wr, int wc, int fr, int fq) const {
        const int row0 = u.pm * BM + wr * 64 + fr; const int col0 = u.pn * BM + wc * 32 + 8 * fq;
#pragma unroll
        for (int ai = 0; ai < 2; ++ai)
#pragma unroll
            for (int m = 0; m < 4; ++m) { bf16_t* rowp = O + (size_t)(row0 + ai * HALF + m * 16) * ldc + col0;
#pragma unroll
                for (int bj = 0; bj < 2; ++bj) { const f32x4 v0 = acc[ai][bj][m][0], v1 = acc[ai][bj][m][1];
                    u32x4 w; w.x = cvt_pk_bf16(v0[0], v0[1]); w.y = cvt_pk_bf16(v0[2], v0[3]); w.z = cvt_pk_bf16(v1[0], v1[1]); w.w = cvt_pk_bf16(v1[2], v1[3]);
                    *(u32x4*)(rowp + bj * HALF) = w; } }
        if (u.pn == pn_low && wc == 0) {
#pragma unroll
            for (int ai = 0; ai < 2; ++ai)
#pragma unroll
                for (int m = 0; m < 4; ++m) { float* ap = alow + (size_t)(row0 + ai * HALF + m * 16) * 32 + 8 * fq;
                    *(f32x4*)(ap) = acc[ai][0][m][0]; *(f32x4*)(ap + 4) = acc[ai][0][m][1]; }
        }
    }
};
struct EpiResid {
    static constexpr bool PERM = false, AFTER_DRAIN = false;
    const float* base; float* out; const float* gate; int gstride; int rows_per_b; int ldc;
    __device__ __forceinline__ void operator()(const f32x4 (&acc)[2][2][4][2], const Unit& u, int wr, int wc, int fr, int fq) const {
        const int row0 = u.pm * BM + wr * 64 + fr, col0 = u.pn * BM + wc * 32 + 4 * fq;
        const int b = (u.pm * BM) / rows_per_b;
        f32x4 gv[2][2];
#pragma unroll
        for (int bj = 0; bj < 2; ++bj)
#pragma unroll
            for (int n = 0; n < 2; ++n) gv[bj][n] = *(const f32x4*)(gate + (size_t)b * gstride + col0 + bj * HALF + n * 16);
#pragma unroll
        for (int ai = 0; ai < 2; ++ai)
#pragma unroll
            for (int m = 0; m < 4; ++m) { const size_t off = (size_t)(row0 + ai * HALF + m * 16) * ldc + col0;
#pragma unroll
                for (int bj = 0; bj < 2; ++bj)
#pragma unroll
                    for (int n = 0; n < 2; ++n) { const f32x4 bs = *(const f32x4*)(base + off + bj * HALF + n * 16);
                        *(f32x4*)(out + off + bj * HALF + n * 16) = bs + gv[bj][n] * acc[ai][bj][m][n]; } }
    }
};

template <class Epi, class Sched, bool ALIGN_EPI = false, bool SP2 = false>
__device__ __forceinline__ void gemm_phase(PG8_LAS unsigned char* lds, const Gemm g, const Sched& S, const Epi& E) {
    const int tid = threadIdx.x, wid = __builtin_amdgcn_readfirstlane(tid >> 6), lane = tid & 63, wr = wid >> 2, wc = wid & 3, fr = lane & 15, fq = lane >> 4;
    const int K = g.K, nt = K / BK;
    unsigned voffA[2], voffB[2];
#pragma unroll
    for (int i = 0; i < 2; ++i) { int R, C; stage_rc(tid * 16 + i * 8192, R, C); const int Rb = Epi::PERM ? ((R & ~31) + perm32(R & 31)) : R;
        voffA[i] = (unsigned)(R * K + C) * 2u; voffB[i] = (unsigned)(Rb * K + C) * 2u; }
    const size_t kstep = (size_t)(BK * 2);
    const size_t hstep = (size_t)HALF * K * 2;
    const size_t tstep = 2 * hstep;
    const unsigned ldsw = (unsigned)wid * 1024u;
    const int aoff = lds_byte(wr * 64 + fr, fq * 8), boff = lds_byte(wc * 32 + fr, fq * 8);
#define PG8_SA(b, h) (((b) * 2 + (h)) * HTB)
#define PG8_SB(b, h) ((4 + (b) * 2 + (h)) * HTB)
#define PG8_STAGE(bufoff, gbase, voff) do { _Pragma("unroll") for (int _i = 0; _i < 2; ++_i) \
        __builtin_amdgcn_global_load_lds((const unsigned*)((const char*)(gbase) + (voff)[_i]), (PG8_LAS unsigned*)(lds + (bufoff) + ldsw + _i * 8192), 16, 0, 0); } while (0)
#define PG8_LDA(dst, b, h) do { _Pragma("unroll") for (int m = 0; m < 4; ++m) _Pragma("unroll") for (int k = 0; k < 2; ++k) dst[m][k] = *(const PG8_LAS bf16x8*)(lds + PG8_SA(b, h) + aoff + m * 2048 + k * 1024); } while (0)
#define PG8_LDB(dst, b, h) do { _Pragma("unroll") for (int n = 0; n < 2; ++n) _Pragma("unroll") for (int k = 0; k < 2; ++k) dst[n][k] = *(const PG8_LAS bf16x8*)(lds + PG8_SB(b, h) + boff + n * 2048 + k * 1024); } while (0)
#define PG8_MMA(ai, bj, At, Bt) do { __builtin_amdgcn_s_setprio(1); _Pragma("unroll") for (int m = 0; m < 4; ++m) _Pragma("unroll") for (int n = 0; n < 2; ++n) _Pragma("unroll") for (int k = 0; k < 2; ++k) \
        acc[ai][bj][m][n] = __builtin_amdgcn_mfma_f32_16x16x32_bf16(Bt[n][k], At[m][k], acc[ai][bj][m][n], 0, 0, 0); __builtin_amdgcn_s_setprio(0); } while (0)
#define PG8_WAIT_V(n) asm volatile("s_waitcnt vmcnt(" #n ")" ::: "memory")
#define PG8_WAIT_L(n) asm volatile("s_waitcnt lgkmcnt(" #n ")" ::: "memory")
#define PG8_BAR __builtin_amdgcn_s_barrier()
#define PG8_SCHED __builtin_amdgcn_sched_barrier(0)
    Unit cur, nxt; int ui = 0;
    if (!S.next(0, cur)) return;
    f32x4 acc[2][2][4][2];
#pragma unroll
    for (int a = 0; a < 2; ++a)
#pragma unroll
        for (int b = 0; b < 2; ++b)
#pragma unroll
            for (int m = 0; m < 4; ++m)
#pragma unroll
                for (int n = 0; n < 2; ++n) acc[a][b][m][n] = (f32x4){0.f, 0.f, 0.f, 0.f};
    bf16x8 At[4][2], B0[2][2], B1[2][2];
    const char* cA = (const char*)g.A + (size_t)cur.pm * tstep; const char* cB = (const char*)g.Bt + (size_t)cur.pn * tstep;
    S.a_ready(cur);
    if constexpr (SP2) {
        PG8_STAGE(PG8_SB(0, 0), cB, voffB); PG8_STAGE(PG8_SB(0, 1), cB + hstep, voffB); PG8_STAGE(PG8_SA(0, 0), cA, voffA); PG8_STAGE(PG8_SA(0, 1), cA + hstep, voffA);
        if (wr == 1) PG8_BAR;
        PG8_WAIT_V(2); PG8_BAR;
        PG8_STAGE(PG8_SB(1, 0), cB + kstep, voffB); PG8_STAGE(PG8_SA(1, 0), cA + kstep, voffA); PG8_STAGE(PG8_SB(1, 1), cB + hstep + kstep, voffB);
        PG8_WAIT_V(6); PG8_BAR;
    } else {
        PG8_STAGE(PG8_SB(0, 0), cB, voffB); PG8_STAGE(PG8_SA(0, 0), cA, voffA); PG8_STAGE(PG8_SB(0, 1), cB + hstep, voffB); PG8_STAGE(PG8_SA(0, 1), cA + hstep, voffA);
        if (wr == 1) PG8_BAR;
        PG8_WAIT_V(4); PG8_BAR;
        PG8_STAGE(PG8_SB(1, 0), cB + kstep, voffB); PG8_STAGE(PG8_SA(1, 0), cA + kstep, voffA); PG8_STAGE(PG8_SB(1, 1), cB + hstep + kstep, voffB);
        PG8_WAIT_V(6); PG8_BAR;
    }
    for (;;) {
        const bool has_next = S.next(ui + 1, nxt);
        const char* nA = has_next ? (const char*)g.A + (size_t)nxt.pm * tstep : cA; const char* nB = has_next ? (const char*)g.Bt + (size_t)nxt.pn * tstep : cB;
        for (int t = 0; t < nt; t += 2) {
            const bool last = (t == nt - 2);
            const char* a1 = cA + (size_t)(t + 1) * kstep;
            const char* a2 = last ? nA : cA + (size_t)(t + 2) * kstep; const char* b2 = last ? nB : cB + (size_t)(t + 2) * kstep;
            const char* a3 = a2 + kstep; const char* b3 = b2 + kstep;
            if (last && has_next) S.a_ready(nxt);
            if constexpr (SP2) {
            PG8_LDB(B0, 0, 0); PG8_LDB(B1, 0, 1); PG8_SCHED; PG8_LDA(At, 0, 0); PG8_STAGE(PG8_SA(1, 1), a1 + hstep, voffA);
            PG8_WAIT_V(8); PG8_WAIT_L(0); PG8_BAR; PG8_MMA(0, 0, At, B0); PG8_MMA(0, 1, At, B1); PG8_BAR; PG8_SCHED;
            PG8_LDA(At, 0, 1); PG8_STAGE(PG8_SB(0, 0), b2, voffB); PG8_STAGE(PG8_SB(0, 1), b2 + hstep, voffB); PG8_STAGE(PG8_SA(0, 0), a2, voffA);
            PG8_WAIT_V(8); PG8_WAIT_L(0); PG8_BAR; PG8_MMA(1, 0, At, B0); PG8_MMA(1, 1, At, B1); PG8_BAR; PG8_SCHED;
            PG8_LDB(B0, 1, 0); PG8_LDB(B1, 1, 1); PG8_SCHED; PG8_LDA(At, 1, 0); PG8_STAGE(PG8_SA(0, 1), a2 + hstep, voffA);
            PG8_WAIT_V(8); PG8_WAIT_L(0); PG8_BAR; PG8_MMA(0, 0, At, B0); PG8_MMA(0, 1, At, B1); PG8_BAR; PG8_SCHED;
            PG8_LDA(At, 1, 1); PG8_STAGE(PG8_SB(1, 0), b3, voffB); PG8_STAGE(PG8_SB(1, 1), b3 + hstep, voffB); PG8_STAGE(PG8_SA(1, 0), a3, voffA);
            PG8_WAIT_V(8); PG8_WAIT_L(0); PG8_BAR; PG8_MMA(1, 0, At, B0); PG8_MMA(1, 1, At, B1); PG8_BAR; PG8_SCHED;
            } else {
            PG8_LDB(B0, 0, 0); PG8_SCHED; PG8_LDA(At, 0, 0); PG8_STAGE(PG8_SA(1, 1), a1 + hstep, voffA);
            PG8_WAIT_L(8); PG8_BAR; PG8_WAIT_L(0); PG8_MMA(0, 0, At, B0); PG8_BAR; PG8_SCHED;
            PG8_LDB(B1, 0, 1); PG8_STAGE(PG8_SB(0, 0), b2, voffB);
            PG8_BAR; PG8_WAIT_L(0); PG8_MMA(0, 1, At, B1); PG8_BAR;
            PG8_LDA(At, 0, 1); PG8_STAGE(PG8_SA(0, 0), a2, voffA);
            PG8_BAR; PG8_WAIT_L(0); PG8_MMA(1, 0, At, B0); PG8_BAR; PG8_SCHED;
            PG8_STAGE(PG8_SB(0, 1), b2 + hstep, voffB);
            PG8_WAIT_V(6); PG8_BAR; PG8_MMA(1, 1, At, B1); PG8_BAR;
            PG8_LDB(B0, 1, 0); PG8_SCHED; PG8_LDA(At, 1, 0); PG8_STAGE(PG8_SA(0, 1), a2 + hstep, voffA);
            PG8_WAIT_L(8); PG8_BAR; PG8_WAIT_L(0); PG8_MMA(0, 0, At, B0); PG8_BAR; PG8_SCHED;
            PG8_LDB(B1, 1, 1); PG8_STAGE(PG8_SB(1, 0), b3, voffB);
            PG8_BAR; PG8_WAIT_L(0); PG8_MMA(0, 1, At, B1); PG8_BAR;
            PG8_LDA(At, 1, 1); PG8_STAGE(PG8_SA(1, 0), a3, voffA);
            PG8_BAR; PG8_WAIT_L(0); PG8_MMA(1, 0, At, B0); PG8_BAR; PG8_SCHED;
            PG8_STAGE(PG8_SB(1, 1), b3 + hstep, voffB);
            PG8_WAIT_V(6); PG8_BAR; PG8_MMA(1, 1, At, B1); PG8_BAR;
            }
        }
        if constexpr (ALIGN_EPI) { if (wr == 0) PG8_BAR; }
        if constexpr (!Epi::AFTER_DRAIN) { E(acc, cur, wr, wc, fr, fq); S.done(cur); }
        if (!has_next) break;
#pragma unroll
        for (int a = 0; a < 2; ++a)
#pragma unroll
            for (int b = 0; b < 2; ++b)
#pragma unroll
                for (int m = 0; m < 4; ++m)
#pragma unroll
                    for (int n = 0; n < 2; ++n) acc[a][b][m][n] = (f32x4){0.f, 0.f, 0.f, 0.f};
        cur = nxt; cA = nA; cB = nB; ++ui;
        if constexpr (ALIGN_EPI) { if (wr == 1) PG8_BAR; }
    }
    PG8_WAIT_V(0);
    if constexpr (!ALIGN_EPI) { if (wr == 0) PG8_BAR; }
    PG8_BAR;
    if constexpr (Epi::AFTER_DRAIN) { E.fused(acc, cur, wr, wc, fr, fq, lds, wid, lane); S.done(cur); }
#undef PG8_SA
#undef PG8_SB
#undef PG8_STAGE
#undef PG8_LDA
#undef PG8_LDB
#undef PG8_MMA
#undef PG8_WAIT_V
#undef PG8_WAIT_L
#undef PG8_BAR
#undef PG8_SCHED
}
}

#define LAS __attribute__((address_space(3)))
typedef unsigned short bf16;
typedef unsigned v4u __attribute__((ext_vector_type(4)));
typedef unsigned v2u __attribute__((ext_vector_type(2)));
typedef float f32x4 __attribute__((ext_vector_type(4)));
constexpr int D = 1024, BATCH = 16, SEQ = 2048, NTOK = BATCH * SEQ, CTXL = 256, NCTX = BATCH * CTXL, MROWS = NTOK + NCTX;
constexpr int GIN = 3104, GINP = 3328, KD = 512, VD = 1024, RANK = 16, HK = 128, HV = 256;
constexpr int FH = 2560, FUP = 5120, NMOD = 6144, MODROWS = 17;
constexpr float EPS = 1e-6f;
constexpr int NWAVES = 8, NTHREADS = 512;
constexpr int LDS_BYTES = 159744;
constexpr int LDS_MISC = LDS_BYTES - 256;
constexpr int CW_BAR = 4096;
enum { I_X = 0, I_C, I_CTX, I_CCTX, I_ADAW, I_ADAB, I_NMIX, I_NFFN, I_GWIN, I_GWA2, I_GBA, I_GHN, I_GWOUT, I_SCWIN, I_SCCW, I_SCWOUT, I_FUP, I_FCW, I_FCB, I_FDN, I_FINAL, N_IN };
constexpr size_t MiB = 1u << 20;
constexpr size_t WS_CTL = 0, CTL_ZERO_BYTES = 1 * MiB;
constexpr size_t WS_MOD = 1 * MiB;
constexpr size_t WS_WIN = 2 * MiB;
constexpr size_t WS_WOUT = 9 * MiB;
constexpr size_t WS_SCIN = 11 * MiB;
constexpr size_t WS_SCOUT = 17 * MiB;
constexpr size_t WS_WUP = 19 * MiB;
constexpr size_t WS_WDN = 39 * MiB;
constexpr size_t WS_ALOW = 49 * MiB;
constexpr size_t WS_HN = 56 * MiB;
constexpr size_t WS_PROJ = 128 * MiB;
constexpr size_t WS_OF = 362 * MiB, WS_OB = 426 * MiB;
constexpr size_t WS_U = 128 * MiB;
constexpr size_t WS_ACT = 288 * MiB;
constexpr size_t WS_BCV = 128 * MiB;
constexpr size_t WS_END = 490 * MiB;

__device__ __forceinline__ unsigned f2bf(float f) { unsigned u = __builtin_bit_cast(unsigned, f); return (u + 0x7fffu + ((u >> 16) & 1u)) >> 16; }
__device__ __forceinline__ unsigned pk2(float lo, float hi) { return f2bf(lo) | (f2bf(hi) << 16); }
__device__ __forceinline__ float bflo(unsigned w) { return __builtin_bit_cast(float, w << 16); }
__device__ __forceinline__ float bfhi(unsigned w) { return __builtin_bit_cast(float, w & 0xffff0000u); }
__device__ __forceinline__ float bf2f(bf16 h) { return __builtin_bit_cast(float, ((unsigned)h) << 16); }
__device__ __forceinline__ float silu_f(float v) { return v / (1.0f + __expf(-v)); }
__device__ __forceinline__ float wave_sum(float v) {
#pragma unroll
    for (int o = 1; o < 64; o <<= 1) v += __shfl_xor(v, o);
    return v;
}
__device__ __forceinline__ void unpack8(const v4u w, float (&f)[8]) { f[0] = bflo(w.x); f[1] = bfhi(w.x); f[2] = bflo(w.y); f[3] = bfhi(w.y); f[4] = bflo(w.z); f[5] = bfhi(w.z); f[6] = bflo(w.w); f[7] = bfhi(w.w); }
__device__ __forceinline__ v4u pack8(const float (&f)[8]) { v4u w; w.x = pk2(f[0], f[1]); w.y = pk2(f[2], f[3]); w.z = pk2(f[4], f[5]); w.w = pk2(f[6], f[7]); return w; }

struct Params { const float* in[N_IN]; float* out; unsigned char* ws; int ph_lo, ph_hi; };

__device__ __forceinline__ void transpose_item(const float* W, int K, int N, bf16* WT, int k0, int n0, int rowbase, LAS float* scr, int lane) {
#pragma unroll 8
    for (int i = 0; i < 32; ++i) { const int kk = 2 * i + (lane >> 5); scr[kk * 33 + (lane & 31)] = W[(size_t)(k0 + kk) * N + n0 + (lane & 31)]; }
    asm volatile("s_waitcnt lgkmcnt(0)" ::: "memory");
    const int c = lane & 7;
#pragma unroll
    for (int j = 0; j < 4; ++j) { const int n = (lane >> 3) + 8 * j; const LAS float* s = scr + (8 * c) * 33 + n;
        v4u o; o.x = pk2(s[0 * 33], s[1 * 33]); o.y = pk2(s[2 * 33], s[3 * 33]); o.z = pk2(s[4 * 33], s[5 * 33]); o.w = pk2(s[6 * 33], s[7 * 33]);
        *(v4u*)(WT + (size_t)(rowbase + n) * K + k0 + 8 * c) = o; }
    asm volatile("s_waitcnt lgkmcnt(0)" ::: "memory");
}
__device__ __forceinline__ int uprow(int n) { return n < FH ? ((n >> 7) * 256 + (n & 127)) : ((((n - FH) >> 7) * 256) + 128 + ((n - FH) & 127)); }

__device__ __forceinline__ void phase_prep(const Params& P, LAS unsigned char* lds, int tid, int wave, int lane) {
    const int G = gridDim.x, gw = blockIdx.x * NWAVES + wave, NGW = G * NWAVES;
    unsigned char* ws = P.ws;
    LAS float* scr = (LAS float*)(lds + wave * 16384);
    constexpr int I_WIN = (D / 64) * (GIN / 32), I_WOUT = (D / 64) * (D / 32), I_SCIN = (D / 64) * (3 * D / 32), I_UP = (D / 64) * (FUP / 32), I_DN = (FH / 64) * (D / 32);
    constexpr int NITEMS = I_WIN + 2 * I_WOUT + I_SCIN + 2 * I_UP + 2 * I_DN;
    for (int it = gw; it < NITEMS; it += NGW) {
        int r = it;
        if (r < I_WIN) { const int nb = GIN / 32, kb = r / nb, n0 = 32 * (r % nb); transpose_item(P.in[I_GWIN], D, GIN, (bf16*)(ws + WS_WIN), 64 * kb, n0, n0, scr, lane); continue; } r -= I_WIN;
        if (r < I_WOUT) { const int nb = D / 32, kb = r / nb, n0 = 32 * (r % nb); transpose_item(P.in[I_GWOUT], D, D, (bf16*)(ws + WS_WOUT), 64 * kb, n0, n0, scr, lane); continue; } r -= I_WOUT;
        if (r < I_WOUT) { const int nb = D / 32, kb = r / nb, n0 = 32 * (r % nb); transpose_item(P.in[I_SCWOUT], D, D, (bf16*)(ws + WS_SCOUT), 64 * kb, n0, n0, scr, lane); continue; } r -= I_WOUT;
        if (r < I_SCIN) { const int nb = 3 * D / 32, kb = r / nb, n0 = 32 * (r % nb); transpose_item(P.in[I_SCWIN], D, 3 * D, (bf16*)(ws + WS_SCIN), 64 * kb, n0, n0, scr, lane); continue; } r -= I_SCIN;
        if (r < 2 * I_UP) { const int l = r / I_UP; r -= l * I_UP; const int nb = FUP / 32, kb = r / nb, n0 = 32 * (r % nb);
            transpose_item(P.in[I_FUP] + (size_t)l * D * FUP, D, FUP, (bf16*)(ws + WS_WUP) + (size_t)l * FUP * D, 64 * kb, n0, uprow(n0), scr, lane); continue; } r -= 2 * I_UP;
        { const int l = r / I_DN; r -= l * I_DN; const int nb = D / 32, kb = r / nb, n0 = 32 * (r % nb);
            transpose_item(P.in[I_FDN] + (size_t)l * FH * D, FH, D, (bf16*)(ws + WS_WDN) + (size_t)l * D * FH, 64 * kb, n0, n0, scr, lane); }
    }
    { v4u* z = (v4u*)((bf16*)(ws + WS_WIN) + (size_t)GIN * D); const int n16 = (GINP - GIN) * D * 2 / 16;
      for (int i = blockIdx.x * NTHREADS + tid; i < n16; i += G * NTHREADS) z[i] = (v4u){0u, 0u, 0u, 0u}; }
    __syncthreads();
    if ((int)blockIdx.x < 192) {
        LAS float* s = (LAS float*)lds;
        LAS float* red = s + MODROWS * D;
        for (int i = tid; i < MODROWS * D; i += NTHREADS) { const int b = i >> 10, k = i & 1023; const float cv = b < 16 ? P.in[I_C][b * D + k] : P.in[I_CCTX][k]; s[i] = silu_f(cv); }
        __syncthreads();
        float* MOD = (float*)(ws + WS_MOD);
        for (int it = blockIdx.x; it < 192; it += G) {
            const int layer = it / 96, cb = it % 96, col = cb * 64 + lane;
            const float* W = P.in[I_ADAW] + (size_t)layer * D * NMOD;
            float acc[MODROWS];
#pragma unroll
            for (int b = 0; b < MODROWS; ++b) acc[b] = 0.f;
            for (int k = wave * 128; k < wave * 128 + 128; k += 4) {
                const float w0 = W[(size_t)(k + 0) * NMOD + col], w1 = W[(size_t)(k + 1) * NMOD + col], w2 = W[(size_t)(k + 2) * NMOD + col], w3 = W[(size_t)(k + 3) * NMOD + col];
#pragma unroll
                for (int b = 0; b < MODROWS; ++b) { const f32x4 sv = *(const LAS f32x4*)(s + b * D + k); acc[b] += sv[0] * w0 + sv[1] * w1 + sv[2] * w2 + sv[3] * w3; }
            }
#pragma unroll
            for (int b = 0; b < MODROWS; ++b) red[(wave * MODROWS + b) * 64 + lane] = acc[b];
            __syncthreads();
            for (int o = tid; o < MODROWS * 64; o += NTHREADS) { const int b = o >> 6, l = o & 63; float sum = 0.f;
#pragma unroll
                for (int w = 0; w < NWAVES; ++w) sum += red[(w * MODROWS + b) * 64 + l];
                MOD[(size_t)(layer * MODROWS + b) * NMOD + cb * 64 + l] = sum + P.in[I_ADAB][layer * NMOD + cb * 64 + l]; }
            __syncthreads();
        }
    }
}

__device__ __forceinline__ void modulate_rows(const float* src, int nrows, int rows_per_b, int bfix, const float* gain, const float* mod, int shift_i, int scale_i, bf16* dst, int gw, int NGW, int lane) {
    for (int row = gw; row < nrows; row += NGW) {
        const int b = bfix >= 0 ? bfix : row / rows_per_b;
        const f32x4* xr = (const f32x4*)(src + (size_t)row * D) + lane;
        f32x4 v[4]; float ss = 0.f;
#pragma unroll
        for (int j = 0; j < 4; ++j) { v[j] = xr[64 * j]; ss += (v[j][0] * v[j][0] + v[j][1] * v[j][1]) + (v[j][2] * v[j][2] + v[j][3] * v[j][3]); }
        const float rstd = 1.0f / sqrtf(wave_sum(ss) * (1.0f / D) + EPS);
        const float* sh = mod + (size_t)b * NMOD + shift_i * D; const float* sc = mod + (size_t)b * NMOD + scale_i * D;
        v2u* o8 = (v2u*)(dst + (size_t)row * D) + lane;
#pragma unroll
        for (int j = 0; j < 4; ++j) { const int idx = 4 * lane + 256 * j; const f32x4 g = *(const f32x4*)(gain + idx), s4 = *(const f32x4*)(sh + idx), c4 = *(const f32x4*)(sc + idx);
            const f32x4 y = ((v[j] * rstd) * g) * (c4 + 1.0f) + s4; v2u w; w.x = pk2(y[0], y[1]); w.y = pk2(y[2], y[3]); o8[64 * j] = w; }
    }
}
__device__ __forceinline__ void final_norm_rows(float* h, const float* gain, int gw, int NGW, int lane) {
    for (int row = gw; row < NTOK; row += NGW) {
        f32x4* xr = (f32x4*)(h + (size_t)row * D) + lane;
        f32x4 v[4]; float ss = 0.f;
#pragma unroll
        for (int j = 0; j < 4; ++j) { v[j] = xr[64 * j]; ss += (v[j][0] * v[j][0] + v[j][1] * v[j][1]) + (v[j][2] * v[j][2] + v[j][3] * v[j][3]); }
        const float rstd = 1.0f / sqrtf(wave_sum(ss) * (1.0f / D) + EPS);
#pragma unroll
        for (int j = 0; j < 4; ++j) { const f32x4 g = *(const f32x4*)(gain + 4 * lane + 256 * j); xr[64 * j] = (v[j] * rstd) * g; }
    }
}

__device__ __forceinline__ void phase_scan_naive(const Params& P, LAS unsigned char* lds, int tid) {
    const int half = tid >> 8, t8 = tid & 255;
    LAS float* buf = (LAS float*)lds + half * 768;
    const bf16* PROJ = (const bf16*)(P.ws + WS_PROJ); const float* ALOW = (const float*)(P.ws + WS_ALOW);
    for (int it0 = blockIdx.x * 2; it0 < BATCH * 4 * 2; it0 += gridDim.x * 2) {
        const int item = it0 + half, b = item >> 3, h = (item >> 1) & 3, dir = item & 1;
        bf16* O = (bf16*)(P.ws + (dir ? WS_OB : WS_OF));
        float S[HK];
#pragma unroll
        for (int c = 0; c < HK; ++c) S[c] = 0.f;
        float w2[RANK], ba = 0.f;
#pragma unroll
        for (int r = 0; r < RANK; ++r) w2[r] = 0.f;
        if (t8 < HK) {
#pragma unroll
            for (int r = 0; r < RANK; ++r) w2[r] = P.in[I_GWA2][(dir * RANK + r) * KD + h * HK + t8];
            ba = P.in[I_GBA][dir * KD + h * HK + t8]; }
        for (int step = 0; step < CTXL + SEQ; ++step) {
            const bool isctx = step < CTXL; const int idx = isctx ? step : step - CTXL, n = isctx ? CTXL : SEQ, pos = dir ? n - 1 - idx : idx;
            const size_t row = isctx ? (size_t)NTOK + b * CTXL + pos : (size_t)b * SEQ + pos;
            LAS float* cur = buf + (step & 1) * 384;
            const bf16* pr = PROJ + row * GINP;
            if (t8 < HK) {
                const float q = bf2f(pr[h * HK + t8]) * 0.08838834764831845f, k = bf2f(pr[KD + h * HK + t8]);
                const float* al = ALOW + row * 32 + dir * RANK; float z = ba;
#pragma unroll
                for (int r = 0; r < RANK; ++r) z += al[r] * w2[r];
                const float ls = fminf(z, 0.f) - log1pf(expf(-fabsf(z)));
                cur[t8] = q; cur[128 + t8] = k; cur[256 + t8] = expf(ls * (1.0f / 16.0f));
            }
            const float v = bf2f(pr[2 * KD + h * HV + t8]);
            __syncthreads();
            float o = 0.f;
#pragma unroll
            for (int c = 0; c < HK; c += 4) { const f32x4 q4 = *(const LAS f32x4*)(cur + c), k4 = *(const LAS f32x4*)(cur + 128 + c), a4 = *(const LAS f32x4*)(cur + 256 + c);
#pragma unroll
                for (int j = 0; j < 4; ++j) { S[c + j] = a4[j] * S[c + j] + k4[j] * v; o += q4[j] * S[c + j]; } }
            if (!isctx) O[row * VD + h * HV + t8] = (bf16)f2bf(o);
        }
    }
}

__device__ __forceinline__ void phase_gate(const Params& P, int gw, int NGW, int lane) {
    const bf16* OF = (const bf16*)(P.ws + WS_OF); const bf16* OB = (const bf16*)(P.ws + WS_OB); const bf16* PROJ = (const bf16*)(P.ws + WS_PROJ); bf16* A = (bf16*)(P.ws + WS_HN);
    const float* hg = P.in[I_GHN] + ((16 * lane) & 255);
    float hgv[16];
#pragma unroll
    for (int i = 0; i < 16; ++i) hgv[i] = hg[i];
    for (int row = gw; row < NTOK; row += NGW) {
        const v4u* pf = (const v4u*)(OF + (size_t)row * VD + 16 * lane); const v4u* pb = (const v4u*)(OB + (size_t)row * VD + 16 * lane); const v4u* pg = (const v4u*)(PROJ + (size_t)row * GINP + 2 * KD + VD + 16 * lane);
        float o[16], t[8], g[16];
        unpack8(pf[0], t);
#pragma unroll
        for (int i = 0; i < 8; ++i) o[i] = t[i];
        unpack8(pf[1], t);
#pragma unroll
        for (int i = 0; i < 8; ++i) o[8 + i] = t[i];
        unpack8(pb[0], t);
#pragma unroll
        for (int i = 0; i < 8; ++i) o[i] += t[i];
        unpack8(pb[1], t);
#pragma unroll
        for (int i = 0; i < 8; ++i) o[8 + i] += t[i];
        unpack8(pg[0], t);
#pragma unroll
        for (int i = 0; i < 8; ++i) g[i] = t[i];
        unpack8(pg[1], t);
#pragma unroll
        for (int i = 0; i < 8; ++i) g[8 + i] = t[i];
        float ss = 0.f;
#pragma unroll
        for (int i = 0; i < 16; ++i) ss += o[i] * o[i];
        ss += __shfl_xor(ss, 1); ss += __shfl_xor(ss, 2); ss += __shfl_xor(ss, 4); ss += __shfl_xor(ss, 8);
        const float rstd = 1.0f / sqrtf(ss * (1.0f / HV) + EPS);
        float r0[8], r1[8];
#pragma unroll
        for (int i = 0; i < 8; ++i) { r0[i] = ((o[i] * rstd) * hgv[i]) * silu_f(g[i]); r1[i] = ((o[8 + i] * rstd) * hgv[8 + i]) * silu_f(g[8 + i]); }
        v4u* pa = (v4u*)(A + (size_t)row * D + 16 * lane); pa[0] = pack8(r0); pa[1] = pack8(r1);
    }
}

__device__ __forceinline__ void phase_convgate(const Params& P, int layer, int half, int gtid, int NT) {
    const bf16* U = (const bf16*)(P.ws + WS_U); bf16* ACT = (bf16*)(P.ws + WS_ACT);
    const float* cw = P.in[I_FCW] + (size_t)layer * 3 * FUP; const float* cb = P.in[I_FCB] + (size_t)layer * FUP;
    const int NITEM = NTOK * 160;
    for (int it = gtid; it < NITEM; it += NT) {
        const int t = it / 160, cg8 = it % 160, pnl = cg8 >> 4, j = (cg8 & 15) * 8, ch = (half * 10 + pnl) * 128 + j;
        const int gr = (t & (SEQ - 1)) >> 6;
        const bf16* ua = U + (size_t)t * FH + pnl * 256 + j; const bf16* ug = ua + 128;
        float a[8], g[8], tmp[8];
#pragma unroll
        for (int i = 0; i < 8; ++i) { a[i] = cb[ch + i]; g[i] = cb[FH + ch + i]; }
#pragma unroll
        for (int tap = 0; tap < 3; ++tap) {
            const int rr = gr + tap - 1; if (rr < 0 || rr > 31) continue;
            const long off = (long)(tap - 1) * 64 * FH;
            unpack8(*(const v4u*)(ua + off), tmp);
#pragma unroll
            for (int i = 0; i < 8; ++i) a[i] += tmp[i] * cw[tap * FUP + ch + i];
            unpack8(*(const v4u*)(ug + off), tmp);
#pragma unroll
            for (int i = 0; i < 8; ++i) g[i] += tmp[i] * cw[tap * FUP + FH + ch + i];
        }
        float r[8];
#pragma unroll
        for (int i = 0; i < 8; ++i) r[i] = a[i] * silu_f(g[i]);
        *(v4u*)(ACT + (size_t)t * FH + ch) = pack8(r);
    }
}
__device__ __forceinline__ void phase_scconv(const Params& P, int gtid, int NT) {
    const bf16* BCV = (const bf16*)(P.ws + WS_BCV); bf16* A = (bf16*)(P.ws + WS_HN);
    const float* cw = P.in[I_SCCW];
    const int NITEM = NTOK * 128;
    for (int it = gtid; it < NITEM; it += NT) {
        const int t = it >> 7, ch = (it & 127) * 8, col = t & 63;
        const bf16* p = BCV + (size_t)t * (3 * D) + ch;
        float acc[8], bgv[8], c8[8], v8[8];
#pragma unroll
        for (int i = 0; i < 8; ++i) acc[i] = 0.f;
#pragma unroll
        for (int tap = 0; tap < 3; ++tap) {
            const int cc = col + tap - 1; if (cc < 0 || cc > 63) continue;
            const long off = (long)(tap - 1) * 3 * D;
            unpack8(*(const v4u*)(p + off + D), c8); unpack8(*(const v4u*)(p + off + 2 * D), v8);
#pragma unroll
            for (int i = 0; i < 8; ++i) acc[i] += (c8[i] * v8[i]) * cw[tap * D + ch + i];
        }
        unpack8(*(const v4u*)p, bgv);
        float r[8];
#pragma unroll
        for (int i = 0; i < 8; ++i) r[i] = bgv[i] * acc[i];
        *(v4u*)(A + (size_t)t * D + ch) = pack8(r);
    }
}


namespace scn {
typedef short bf16x8 __attribute__((ext_vector_type(8)));
typedef short s16x4 __attribute__((ext_vector_type(4)));
typedef float f32x16 __attribute__((ext_vector_type(16)));
typedef float f32x2 __attribute__((ext_vector_type(2)));
typedef __bf16 bf16x2 __attribute__((ext_vector_type(2)));
constexpr int OFF_Q = 0, OFF_K = 16384, OFF_V = 32768, OFF_AL = 49152, BUF = 53248;
constexpr int OFF_P = 2 * BUF, OFF_TOT = OFF_P + 8192, OFF_EL = OFF_TOT + 4096, OFF_X = OFF_EL + 512, LDS_END = OFF_X + 32768;
__device__ __forceinline__ unsigned offb(unsigned row, unsigned ch) { return 256u * row + 16u * (ch ^ (((row & 3u) << 2) | ((row >> 2) & 3u))); }
__device__ __forceinline__ unsigned offp(unsigned i, unsigned ch) { return 128u * i + 16u * (ch ^ ((i >> 1) & 7u)); }
__device__ __forceinline__ unsigned cvtpk(float lo, float hi) { const f32x2 v = {lo, hi}; return __builtin_bit_cast(unsigned, __builtin_convertvector(v, bf16x2)); }
__device__ __forceinline__ s16x4 trrd(LAS unsigned char* p) { return __builtin_bit_cast(s16x4, __builtin_amdgcn_ds_read_tr16_b64_v4i16((LAS s16x4*)p)); }
__device__ __forceinline__ bf16x8 trfrag(LAS unsigned char* img, int lane, int c, int ks) {
    const unsigned h = lane >> 5, blk = (lane >> 4) & 1, q = (lane & 15) >> 2, p = lane & 3;
    const s16x4 lo = trrd(img + offb(16 * ks + 8 * h + q, 4 * c + 2 * blk + (p >> 1)) + 8 * (p & 1));
    const s16x4 hi = trrd(img + offb(16 * ks + 8 * h + 4 + q, 4 * c + 2 * blk + (p >> 1)) + 8 * (p & 1));
    return __builtin_shufflevector(lo, hi, 0, 1, 2, 3, 4, 5, 6, 7);
}
__device__ __forceinline__ bf16x8 pack_step(const f32x16& x, int s) {
    v4u p; p.x = cvtpk(x[8 * s], x[8 * s + 1]); p.y = cvtpk(x[8 * s + 2], x[8 * s + 3]); p.z = cvtpk(x[8 * s + 4], x[8 * s + 5]); p.w = cvtpk(x[8 * s + 6], x[8 * s + 7]);
    return __builtin_bit_cast(bf16x8, p);
}
#define MFMA32(a, b, c) __builtin_amdgcn_mfma_f32_32x32x16_bf16((a), (b), (c), 0, 0, 0)
#define MFMA16(a, b, c) __builtin_amdgcn_mfma_f32_16x16x32_bf16((a), (b), (c), 0, 0, 0)

__device__ __forceinline__ void phase_scan(const Params& P, LAS unsigned char* lds, int tid, int wave, int lane) {
    const bf16* PROJ = (const bf16*)(P.ws + WS_PROJ); const float* ALOW = (const float*)(P.ws + WS_ALOW);
    const int ch = wave >> 2, dq = wave & 3;
    for (int item = blockIdx.x; item < BATCH * 4 * 2 * 2; item += gridDim.x) {
        const int b = item >> 4, h = (item >> 2) & 3, dir = (item >> 1) & 1, dvh = item & 1;
        bf16* O = (bf16*)(P.ws + (dir ? WS_OB : WS_OF));
        float w2a[RANK], w2b[RANK];
#pragma unroll
        for (int rr = 0; rr < RANK; ++rr) { const f32x2 w = *(const f32x2*)(P.in[I_GWA2] + (size_t)(dir * RANK + rr) * KD + h * HK + 2 * lane); w2a[rr] = w[0]; w2b[rr] = w[1]; }
        const f32x2 bav = *(const f32x2*)(P.in[I_GBA] + dir * KD + h * HK + 2 * lane);
        f32x16 S[2];
#pragma unroll
        for (int i = 0; i < 16; ++i) { S[0][i] = 0.f; S[1][i] = 0.f; }
        v4u rq[2], rk[2], rv[2], ra;
#define SCN_ROW0(s) ((s) < 4 ? (size_t)NTOK + (size_t)b * CTXL + 64 * (dir ? 3 - (s) : (s)) : (size_t)b * SEQ + 64 * (dir ? 31 - ((s) - 4) : ((s) - 4)))
#define SCN_LOAD(s) do { const size_t row0_ = SCN_ROW0(s); _Pragma("unroll") for (int i_ = 0; i_ < 2; ++i_) { const int cx_ = tid + 512 * i_, rw_ = cx_ >> 4, c16_ = cx_ & 15; \
            const bf16* pr_ = PROJ + (row0_ + rw_) * GINP + 8 * c16_; rq[i_] = *(const v4u*)(pr_ + h * HK); rk[i_] = *(const v4u*)(pr_ + KD + h * HK); rv[i_] = *(const v4u*)(pr_ + 2 * KD + h * HV + dvh * 128); } \
            if (tid < 256) ra = *(const v4u*)(ALOW + (row0_ + (tid >> 2)) * 32 + dir * RANK + 4 * (tid & 3)); } while (0)
#define SCN_STORE(bo) do { _Pragma("unroll") for (int i_ = 0; i_ < 2; ++i_) { const int cx_ = tid + 512 * i_, rw_ = cx_ >> 4, c16_ = cx_ & 15; const unsigned o_ = offb(rw_, c16_); \
            *(LAS v4u*)(lds + (bo) + OFF_Q + o_) = rq[i_]; *(LAS v4u*)(lds + (bo) + OFF_K + o_) = rk[i_]; *(LAS v4u*)(lds + (bo) + OFF_V + o_) = rv[i_]; } \
            if (tid < 256) *(LAS v4u*)(lds + (bo) + OFF_AL + tid * 16) = ra; } while (0)
        SCN_LOAD(0); SCN_STORE(0);
        __syncthreads();
        for (int s = 0; s < 36; ++s) {
            const int bo = (s & 1) * BUF; const bool isctx = s < 4;
            LAS unsigned char* Qi = lds + bo + OFF_Q; LAS unsigned char* Ki = lds + bo + OFF_K; LAS unsigned char* Vi = lds + bo + OFF_V;
            const LAS float* AL = (const LAS float*)(lds + bo + OFF_AL);
            LAS float* TOT = (LAS float*)(lds + OFF_TOT); LAS float* EL = (LAS float*)(lds + OFF_EL);
            int lg = lane; asm volatile("" : "+v"(lg));
            float P0[8], P1[8]; float run0 = 0.f, run1 = 0.f;
#pragma unroll
            for (int t = 0; t < 8; ++t) {
                const int j = 8 * wave + t; float z0 = bav[0], z1 = bav[1];
#pragma unroll
                for (int q4 = 0; q4 < 4; ++q4) { const f32x4 a = *(const LAS f32x4*)(AL + j * 16 + 4 * q4);
#pragma unroll
                    for (int e = 0; e < 4; ++e) { z0 += a[e] * w2a[4 * q4 + e]; z1 += a[e] * w2b[4 * q4 + e]; } }
                const float l0 = (fminf(z0, 0.f) - log1pf(expf(-fabsf(z0)))) * 0.0625f, l1 = (fminf(z1, 0.f) - log1pf(expf(-fabsf(z1)))) * 0.0625f;
                run0 += l0; run1 += l1; P0[t] = run0; P1[t] = run1;
            }
            *(LAS f32x2*)(TOT + wave * 128 + 2 * lg) = (f32x2){run0, run1};
            __syncthreads();
            float off0 = 0.f, off1 = 0.f, T0 = 0.f, T1 = 0.f;
#pragma unroll
            for (int g = 0; g < 8; ++g) { const f32x2 tv = *(const LAS f32x2*)(TOT + g * 128 + 2 * lg); if (g < wave) { off0 += tv[0]; off1 += tv[1]; } T0 += tv[0]; T1 += tv[1]; }
#pragma unroll
            for (int t = 0; t < 8; ++t) {
                const int j = 8 * wave + t;
                const float pre0 = off0 + P0[t], pre1 = off1 + P1[t];
                const float l0 = P0[t] - (t ? P0[t > 0 ? t - 1 : 0] : 0.f), l1 = P1[t] - (t ? P1[t > 0 ? t - 1 : 0] : 0.f);
                const float bc0 = dir ? (T0 - pre0 + l0) : pre0, bc1 = dir ? (T1 - pre1 + l1) : pre1;
                const float e0 = __expf(-bc0), e1 = __expf(-bc1), r0 = __expf(bc0) * 0.08838834764831845f, r1 = __expf(bc1) * 0.08838834764831845f;
                const unsigned ao = offb(j, lg >> 2) + 4 * (lg & 3);
                const unsigned qw = *(const LAS unsigned*)(Qi + ao), kw = *(const LAS unsigned*)(Ki + ao);
                *(LAS unsigned*)(Qi + ao) = cvtpk(bflo(qw) * r0, bfhi(qw) * r1);
                *(LAS unsigned*)(Ki + ao) = cvtpk(bflo(kw) * e0, bfhi(kw) * e1);
            }
            if (wave == 0) *(LAS f32x2*)(EL + 2 * lg) = (f32x2){__expf(T0), __expf(T1)};
            __syncthreads();
            if (!isctx) {
                int la_ = lane; asm volatile("" : "+v"(la_));
                const int i16 = wave & 3, jh = wave >> 2, fr = la_ & 15, fq = la_ >> 4;
                f32x4 at[2] = {{0.f, 0.f, 0.f, 0.f}, {0.f, 0.f, 0.f, 0.f}};
#pragma unroll
                for (int ks = 0; ks < 4; ++ks) {
                    const bf16x8 qf = *(const LAS bf16x8*)(Qi + offb(16 * i16 + fr, 4 * ks + fq));
#pragma unroll
                    for (int jj = 0; jj < 2; ++jj) { const bf16x8 kf = *(const LAS bf16x8*)(Ki + offb(16 * (2 * jh + jj) + fr, 4 * ks + fq)); at[jj] = MFMA16(kf, qf, at[jj]); }
                }
                const int ig = 16 * i16 + fr;
#pragma unroll
                for (int jj = 0; jj < 2; ++jj) { const int j0 = 16 * (2 * jh + jj) + 4 * fq; float m[4];
#pragma unroll
                    for (int e = 0; e < 4; ++e) { const int jg = j0 + e; const bool keep = dir ? (jg >= ig) : (jg <= ig); m[e] = keep ? at[jj][e] : 0.f; }
                    v2u w; w.x = cvtpk(m[0], m[1]); w.y = cvtpk(m[2], m[3]);
                    *(LAS v2u*)(lds + OFF_P + offp(ig, j0 >> 3) + 2 * (j0 & 7)) = w; }
            }
            __syncthreads();
            if (s + 1 < 36) SCN_LOAD(s + 1);
            int lm = lane; asm volatile("" : "+v"(lm));
            const int r = lm & 31, hh = lm >> 5;
            f32x16 o[2];
#pragma unroll
            for (int i = 0; i < 16; ++i) { o[0][i] = 0.f; o[1][i] = 0.f; }
            bf16x8 vf[4];
#pragma unroll
            for (int ks = 0; ks < 4; ++ks) vf[ks] = trfrag(Vi, lm, dq, ks);
            if (!isctx) {
                bf16x8 sb[2][2];
#pragma unroll
                for (int c2 = 0; c2 < 2; ++c2)
#pragma unroll
                    for (int st = 0; st < 2; ++st) sb[c2][st] = pack_step(S[c2], st);
#pragma unroll
                for (int it = 0; it < 2; ++it) {
#pragma unroll
                    for (int c2 = 0; c2 < 2; ++c2)
#pragma unroll
                        for (int st = 0; st < 2; ++st) { const unsigned cch = 8 * ch + 4 * c2 + 2 * st;
                            const s16x4 lo = *(const LAS s16x4*)(Qi + offb(32 * it + r, cch) + 8 * hh), hi = *(const LAS s16x4*)(Qi + offb(32 * it + r, cch + 1) + 8 * hh);
                            o[it] = MFMA32(__builtin_shufflevector(lo, hi, 0, 1, 2, 3, 4, 5, 6, 7), sb[c2][st], o[it]); }
#pragma unroll
                    for (int k2 = 0; k2 < 2; ++k2) { const int ks = 2 * ch + k2; const bf16x8 pa = *(const LAS bf16x8*)(lds + OFF_P + offp(32 * it + r, 2 * ks + hh)); o[it] = MFMA32(pa, ch ? (k2 ? vf[3] : vf[2]) : (k2 ? vf[1] : vf[0]), o[it]); }
                }
            }
#pragma unroll
            for (int c2 = 0; c2 < 2; ++c2)
#pragma unroll
                for (int ks = 0; ks < 4; ++ks) S[c2] = MFMA32(trfrag(Ki, lm, 2 * ch + c2, ks), vf[ks], S[c2]);
#pragma unroll
            for (int c2 = 0; c2 < 2; ++c2)
#pragma unroll
                for (int g = 0; g < 4; ++g) { const f32x4 ev = *(const LAS f32x4*)(EL + 64 * ch + 32 * c2 + 8 * g + 4 * hh);
#pragma unroll
                    for (int e = 0; e < 4; ++e) S[c2][4 * g + e] *= ev[e]; }
            if (!isctx) {
                LAS float* X = (LAS float*)(lds + OFF_X) + wave * 1024 + lm;
#pragma unroll
                for (int i = 0; i < 16; ++i) X[64 * i] = ch ? o[0][i] : o[1][i];
            }
            __syncthreads();
            if (!isctx) {
                const LAS float* X = (const LAS float*)(lds + OFF_X) + (wave ^ 4) * 1024 + lm;
                const size_t row0 = SCN_ROW0(s);
                bf16* op = O + (row0 + 32 * ch) * VD + h * HV + dvh * 128 + 32 * dq + r;
#pragma unroll
                for (int i = 0; i < 16; ++i) { const float v = (ch ? o[1][i] : o[0][i]) + X[64 * i]; op[(size_t)((i & 3) + 8 * (i >> 2) + 4 * hh) * VD] = (bf16)f2bf(v); }
            }
            if (s + 1 < 36) SCN_STORE(BUF - bo);
            __syncthreads();
        }
#undef SCN_ROW0
#undef SCN_LOAD
#undef SCN_STORE
    }
}
#undef MFMA32
#undef MFMA16
}

#define XB_TMO      128
#define XB_XCNT(j)  (256  + 64 * (j))
#define XB_XSUB(j)  (1280 + 64 * (j))
#define XB_XGEN(j)  (2304 + 64 * (j))
#define XB_TOP      3328
#define XB_TOPGEN   3392
#define XCD_BAR_WORDS 3456
#define XB_SPIN_CAP (1u << 18)

__device__ __forceinline__ unsigned xb_ld(unsigned* p)              { return __hip_atomic_load(p, __ATOMIC_RELAXED, __HIP_MEMORY_SCOPE_AGENT); }
__device__ __forceinline__ unsigned xb_add(unsigned* p, unsigned v) { return __hip_atomic_fetch_add(p, v, __ATOMIC_RELAXED, __HIP_MEMORY_SCOPE_AGENT); }
__device__ __forceinline__ unsigned xb_xcc_id() { return (unsigned)__builtin_amdgcn_s_getreg((3 << 11) | 20) & 0xFu; }
#define XB_SPIN(cond, bar) do { unsigned _sp = 0; while (cond) { __builtin_amdgcn_s_sleep(1); \
    if ((++_sp & 255u) == 0u) { if (xb_ld(&(bar)[XB_TMO])) break; if (_sp > XB_SPIN_CAP) { atomicAdd(&(bar)[XB_TMO], 1u); break; } } } } while (0)

struct XcdBarrier {
    unsigned* bar; unsigned x;
    volatile LAS unsigned* st;
};

__device__ __forceinline__ XcdBarrier xcd_barrier_post(unsigned* bar, volatile LAS unsigned* st) {
    XcdBarrier b; b.bar = bar; b.x = xb_xcc_id(); b.st = st;
    if (threadIdx.x == 0) (void)xb_add(&bar[XB_XCNT(b.x)], 1u);
    return b;
}
__device__ __forceinline__ void xcd_barrier_complete(unsigned* bar, unsigned x, unsigned& nloc, unsigned& nx) {
    const unsigned G = gridDim.x * gridDim.y * gridDim.z;
    unsigned sum, cnt, mine, sp = 0u;
    for (;;) {
        sum = 0u; cnt = 0u; mine = 0u;
#pragma unroll
        for (unsigned j = 0; j < 16; ++j) { const unsigned c = xb_ld(&bar[XB_XCNT(j)]); sum += c; cnt += (c > 0u) ? 1u : 0u; mine = (j == x) ? c : mine; }
        if (sum == G) break;
        __builtin_amdgcn_s_sleep(1);
        if ((++sp & 255u) == 0u) { if (xb_ld(&bar[XB_TMO])) break; if (sp > XB_SPIN_CAP) { atomicAdd(&bar[XB_TMO], 1u); break; } }
    }
    nloc = mine > 0u ? mine : 1u; nx = cnt > 0u ? cnt : 1u;
}

__device__ __forceinline__ void xcd_barrier(const XcdBarrier& b) {
    asm volatile("s_waitcnt vmcnt(0)" ::: "memory");
    __syncthreads();
    if (threadIdx.x == 0) {
        unsigned* bar = b.bar;
        __builtin_amdgcn_s_waitcnt(0);
        unsigned nloc = b.st[0], nx = b.st[1];
        if (nloc == 0u) { xcd_barrier_complete(bar, b.x, nloc, nx); b.st[0] = nloc; b.st[1] = nx; }
        const unsigned old = xb_add(&bar[XB_XSUB(b.x)], 1u);
        const unsigned gen = old / nloc;
        if (old + 1u == (gen + 1u) * nloc) {
            __builtin_amdgcn_fence(__ATOMIC_RELEASE, "agent");
            asm volatile("s_waitcnt vmcnt(0)" ::: "memory");
            const unsigned og = xb_add(&bar[XB_TOP], 1u);
            const unsigned tg = og / nx;
            if (og + 1u == (tg + 1u) * nx) xb_add(&bar[XB_TOPGEN], 1u);
            else XB_SPIN(xb_ld(&bar[XB_TOPGEN]) == tg, bar);
            __builtin_amdgcn_fence(__ATOMIC_ACQUIRE, "agent");
            xb_add(&bar[XB_XGEN(b.x)], 1u);
            asm volatile("s_waitcnt vmcnt(0)" ::: "memory");
        } else {
            XB_SPIN(xb_ld(&bar[XB_XGEN(b.x)]) == gen, bar);
            __builtin_amdgcn_fence(__ATOMIC_ACQUIRE, "agent");
            asm volatile("s_waitcnt vmcnt(0)" ::: "memory");
        }
    }
    __syncthreads();
}

enum { PH_PREP = 0, PH_MOD0, PH_GIN, PH_SCAN, PH_GATE, PH_GOUT, PH_FFN0  , PH_MOD1 = PH_FFN0 + 6, PH_SCIN, PH_SCCONV, PH_SCOUT, PH_FFN1, PH_FINAL = PH_FFN1 + 6, N_PHASES };

#define IN(k) (lo <= (k) && (k) < hi)
#define SEAM(k) do { if (IN(k) && IN((k) + 1)) xcd_barrier(bar); } while (0)

__device__ __forceinline__ void ffn_block(const Params& P, LAS unsigned char* lds, const XcdBarrier& bar, int layer, int k0, int lo, int hi) {
    const int tid = threadIdx.x, lane = tid & 63, wave = __builtin_amdgcn_readfirstlane(tid >> 6);
    const int G = gridDim.x, gw = blockIdx.x * NWAVES + wave, NGW = G * NWAVES, gtid = blockIdx.x * NTHREADS + tid, NT = G * NTHREADS;
    unsigned char* ws = P.ws;
    const float* MODL = (const float*)(ws + WS_MOD) + (size_t)layer * MODROWS * NMOD;
    if (IN(k0)) modulate_rows(P.out, NTOK, SEQ, -1, P.in[I_NFFN] + layer * D, MODL, 3, 4, (bf16*)(ws + WS_HN), gw, NGW, lane);
    SEAM(k0);
#pragma unroll
    for (int half = 0; half < 2; ++half) {
        if (IN(k0 + 1 + 2 * half)) {
            pg8::Gemm g{(const bf16*)(ws + WS_HN), (const bf16*)(ws + WS_WUP) + (size_t)layer * FUP * D + (size_t)half * FH * D, NTOK, FH, D};
            pg8::StaticOrder S; S.init(g.M, g.N, G, (int)blockIdx.x);
            pg8::EpiBf16 E{(bf16*)(ws + WS_U), FH};
            pg8::gemm_phase<pg8::EpiBf16, pg8::StaticOrder, true, true>(lds, g, S, E);
        }
        SEAM(k0 + 1 + 2 * half);
        if (IN(k0 + 2 + 2 * half)) phase_convgate(P, layer, half, gtid, NT);
        SEAM(k0 + 2 + 2 * half);
    }
    if (IN(k0 + 5)) {
        pg8::Gemm g{(const bf16*)(ws + WS_ACT), (const bf16*)(ws + WS_WDN) + (size_t)layer * D * FH, NTOK, D, FH};
        pg8::StaticOrder S; S.init(g.M, g.N, G, (int)blockIdx.x);
        pg8::EpiResid E{P.out, P.out, MODL + 5 * D, NMOD, SEQ, D};
        pg8::gemm_phase<pg8::EpiResid, pg8::StaticOrder, true, true>(lds, g, S, E);
    }
    SEAM(k0 + 5);
}

__global__ void __launch_bounds__(NTHREADS, 2) fwd_kernel(Params P) {
    extern __shared__ __attribute__((aligned(16))) unsigned char lds_raw[];
    LAS unsigned char* lds = (LAS unsigned char*)lds_raw;
    const int tid = threadIdx.x, lane = tid & 63, wave = __builtin_amdgcn_readfirstlane(tid >> 6);
    const int G = gridDim.x, gw = blockIdx.x * NWAVES + wave, NGW = G * NWAVES, gtid = blockIdx.x * NTHREADS + tid, NT = G * NTHREADS;
    unsigned char* ws = P.ws;
    const int lo = P.ph_lo, hi = P.ph_hi;
    const float* MOD = (const float*)(ws + WS_MOD);
    bf16* HN = (bf16*)(ws + WS_HN);
    { volatile LAS unsigned* misc = (volatile LAS unsigned*)(lds + LDS_MISC); if (tid < 64) misc[tid] = 0u; }
    __syncthreads();
    const XcdBarrier bar = xcd_barrier_post((unsigned*)(ws + WS_CTL) + CW_BAR, (volatile LAS unsigned*)(lds + LDS_MISC) + 8);

    if (IN(PH_PREP)) phase_prep(P, lds, tid, wave, lane);
    SEAM(PH_PREP);
    if (IN(PH_MOD0)) {
        modulate_rows(P.in[I_X], NTOK, SEQ, -1, P.in[I_NMIX], MOD, 0, 1, HN, gw, NGW, lane);
        modulate_rows(P.in[I_CTX], NCTX, CTXL, 16, P.in[I_NMIX], MOD, 0, 1, HN + (size_t)NTOK * D, gw, NGW, lane);
    }
    SEAM(PH_MOD0);
    if (IN(PH_GIN)) {
        pg8::Gemm g{HN, (const bf16*)(ws + WS_WIN), MROWS, GINP, D};
        pg8::StaticOrder S; S.init(g.M, g.N, G, (int)blockIdx.x);
        pg8::EpiProj E{(bf16*)(ws + WS_PROJ), GINP, (float*)(ws + WS_ALOW), 12};
        pg8::gemm_phase<pg8::EpiProj, pg8::StaticOrder, true, true>(lds, g, S, E);
    }
    SEAM(PH_GIN);
    #ifdef SCAN_NAIVE
    if (IN(PH_SCAN)) phase_scan_naive(P, lds, tid);
#else
    if (IN(PH_SCAN)) scn::phase_scan(P, lds, tid, wave, lane);
#endif
    SEAM(PH_SCAN);
    if (IN(PH_GATE)) phase_gate(P, gw, NGW, lane);
    SEAM(PH_GATE);
    if (IN(PH_GOUT)) {
        pg8::Gemm g{HN, (const bf16*)(ws + WS_WOUT), NTOK, D, D};
        pg8::StaticOrder S; S.init(g.M, g.N, G, (int)blockIdx.x);
        pg8::EpiResid E{P.in[I_X], P.out, MOD + 2 * D, NMOD, SEQ, D};
        pg8::gemm_phase<pg8::EpiResid, pg8::StaticOrder, true, true>(lds, g, S, E);
    }
    SEAM(PH_GOUT);
    ffn_block(P, lds, bar, 0, PH_FFN0, lo, hi);
    if (IN(PH_MOD1)) modulate_rows(P.out, NTOK, SEQ, -1, P.in[I_NMIX] + D, MOD + (size_t)MODROWS * NMOD, 0, 1, HN, gw, NGW, lane);
    SEAM(PH_MOD1);
    if (IN(PH_SCIN)) {
        pg8::Gemm g{HN, (const bf16*)(ws + WS_SCIN), NTOK, 3 * D, D};
        pg8::StaticOrder S; S.init(g.M, g.N, G, (int)blockIdx.x);
        pg8::EpiBf16 E{(bf16*)(ws + WS_BCV), 3 * D};
        pg8::gemm_phase<pg8::EpiBf16, pg8::StaticOrder, true, true>(lds, g, S, E);
    }
    SEAM(PH_SCIN);
    if (IN(PH_SCCONV)) phase_scconv(P, gtid, NT);
    SEAM(PH_SCCONV);
    if (IN(PH_SCOUT)) {
        pg8::Gemm g{HN, (const bf16*)(ws + WS_SCOUT), NTOK, D, D};
        pg8::StaticOrder S; S.init(g.M, g.N, G, (int)blockIdx.x);
        pg8::EpiResid E{P.out, P.out, MOD + (size_t)MODROWS * NMOD + 2 * D, NMOD, SEQ, D};
        pg8::gemm_phase<pg8::EpiResid, pg8::StaticOrder, true, true>(lds, g, S, E);
    }
    SEAM(PH_SCOUT);
    ffn_block(P, lds, bar, 1, PH_FFN1, lo, hi);
    if (IN(PH_FINAL)) final_norm_rows(P.out, P.in[I_FINAL], gw, NGW, lane);
}
#undef IN
#undef SEAM

#ifndef MK_ONE_LAUNCH
#define MK_ONE_LAUNCH 1
#endif
extern "C" void kernel_launch(void* const* d_in, const int* in_sizes, int n_in, void* d_out, int out_size, void* d_ws, size_t ws_size, hipStream_t stream) {
    static int grid = 0;
    if (grid == 0) {
        if (n_in != N_IN || out_size != NTOK * D || ws_size < WS_END) { fprintf(stderr, "kernel_launch: unexpected shapes (n_in %d out %d ws %zu)\n", n_in, out_size, ws_size); grid = -1; return; }
        int dev = 0, cus = 0, per_cu = 0;
        if (hipGetDevice(&dev) != hipSuccess || hipDeviceGetAttribute(&cus, hipDeviceAttributeMultiprocessorCount, dev) != hipSuccess) { grid = -1; return; }
        if (hipFuncSetAttribute((const void*)fwd_kernel, hipFuncAttributeMaxDynamicSharedMemorySize, LDS_BYTES) != hipSuccess) { fprintf(stderr, "kernel_launch: hipFuncSetAttribute failed\n"); grid = -1; return; }
        if (hipOccupancyMaxActiveBlocksPerMultiprocessor(&per_cu, (const void*)fwd_kernel, NTHREADS, LDS_BYTES) != hipSuccess || per_cu < 1) { fprintf(stderr, "kernel_launch: occupancy query says %d\n", per_cu); per_cu = 1; }
        (void)hipGetLastError();
        grid = cus;
    }
    if (grid < 0) return;
    (void)hipMemsetAsync((char*)d_ws + WS_CTL, 0, CTL_ZERO_BYTES, stream);
    Params p{};
    for (int i = 0; i < N_IN; ++i) p.in[i] = (const float*)d_in[i];
    p.out = (float*)d_out; p.ws = (unsigned char*)d_ws;
#if MK_ONE_LAUNCH
    p.ph_lo = 0; p.ph_hi = N_PHASES;
    void* args[] = {&p};
    hipError_t e = hipLaunchCooperativeKernel((const void*)fwd_kernel, dim3(grid), dim3(NTHREADS), args, LDS_BYTES, stream);
    if (e != hipSuccess) fprintf(stderr, "cooperative launch failed: %s (grid %d)\n", hipGetErrorString(e), grid);
#else
    for (int ph = 0; ph < N_PHASES; ++ph) { p.ph_lo = ph; p.ph_hi = ph + 1; hipLaunchKernelGGL(fwd_kernel, dim3(grid), dim3(NTHREADS), LDS_BYTES, stream, p); }
#endif
}
```

```cpp
#include <hip/hip_runtime.h>
#include <hip/hip_cooperative_groups.h>
#include <cstdio>
#include <cstdint>
namespace cg = cooperative_groups;
namespace pg8 {
#define PG8_LAS __attribute__((address_space(3)))
typedef unsigned short bf16_t;
typedef short bf16x8 __attribute__((ext_vector_type(8)));
typedef float f32x4 __attribute__((ext_vector_type(4)));
typedef unsigned u32x4 __attribute__((ext_vector_type(4)));
constexpr int BM = 256, BK = 64, HALF = 128, HTB = HALF * BK * 2  , STAGE_BYTES = 8 * HTB, NXCD = 8, WGM = 8;

__host__ __device__ __forceinline__ int lds_byte(int r, int c) { const int st = (r >> 4) * 2 + (c >> 5), rr = r & 15, cc = c & 31, ob = rr * 64 + cc * 2; return st * 1024 + (ob ^ (((ob >> 9) & 1) << 5)); }
__host__ __device__ __forceinline__ void stage_rc(int b, int& R, int& C) { const int st = b / 1024, sb = b % 1024, swz = sb ^ (((sb >> 9) & 1) << 5); R = (st >> 1) * 16 + swz / 64; C = (st & 1) * 32 + (swz % 64) / 2; }
__host__ __device__ __forceinline__ int perm32(int rho) { const int n = rho >> 4, i = rho & 15; return 8 * (i >> 2) + 4 * n + (i & 3); }

struct Unit { int pm, pn; };
struct Gemm { const bf16_t* A; const bf16_t* Bt; int M, N, K; };

struct StaticOrder {
    int nM, nN, nwg, G, c;
    __host__ __device__ void init(int M, int N, int G_, int c_) { nM = M / BM; nN = N / BM; nwg = nM * nN; G = G_; c = c_; }
    __host__ __device__ bool next(int i, Unit& u) const {
        const long L = (long)i * G + c; if (L >= nwg) return false;
        int wgid = (int)L; { const int q = nwg / NXCD, r = nwg % NXCD, xcd = wgid % NXCD, off = wgid / NXCD; wgid = (xcd < r ? xcd * (q + 1) : r * (q + 1) + (xcd - r) * q) + off; }
        const int nig = WGM * nN, gid = wgid / nig, fm = gid * WGM, gsz = (nM - fm) < WGM ? (nM - fm) : WGM;
        u.pm = fm + ((wgid % nig) % gsz); u.pn = (wgid % nig) / gsz; return true;
    }
    __device__ __forceinline__ void a_ready(const Unit&) const {}
    __device__ __forceinline__ void done(const Unit&) const {}
};


__device__ __forceinline__ unsigned cvt_pk_bf16(float lo, float hi) { unsigned r; asm volatile("v_cvt_pk_bf16_f32 %0, %1, %2" : "=v"(r) : "v"(lo), "v"(hi)); return r; }

struct EpiBf16 {
    static constexpr bool PERM = true, AFTER_DRAIN = false;
    bf16_t* O; int ldc;
    __device__ __forceinline__ void operator()(const f32x4 (&acc)[2][2][4][2], const Unit& u, int wr, int wc, int fr, int fq) const {
        const int row0 = u.pm * BM + wr * 64 + fr; const int col0 = u.pn * BM + wc * 32 + 8 * fq;
#pragma unroll
        for (int ai = 0; ai < 2; ++ai)
#pragma unroll
            for (int m = 0; m < 4; ++m) { bf16_t* rowp = O + (size_t)(row0 + ai * HALF + m * 16) * ldc + col0;
#pragma unroll
                for (int bj = 0; bj < 2; ++bj) { const f32x4 v0 = acc[ai][bj][m][0], v1 = acc[ai][bj][m][1];
                    u32x4 w; w.x = cvt_pk_bf16(v0[0], v0[1]); w.y = cvt_pk_bf16(v0[2], v0[3]); w.z = cvt_pk_bf16(v1[0], v1[1]); w.w = cvt_pk_bf16(v1[2], v1[3]);
                    *(u32x4*)(rowp + bj * HALF) = w; } }
    }
};
struct EpiProj {
    static constexpr bool PERM = true, AFTER_DRAIN = false;
    bf16_t* O; int ldc; float* alow; int pn_low;
    __device__ __forceinline__ void operator()(const f32x4 (&acc)[2][2][4][2], const Unit& u, int wr, int wc, int fr, int fq) const {
        const int row0 = u.pm * BM + wr * 64 + fr; const int col0 = u.pn * BM + wc * 32 + 8 * fq;
#pragma unroll
        for (int ai = 0; ai < 2; ++ai)
#pragma unroll
            for (int m = 0; m < 4; ++m) { bf16_t* rowp = O + (size_t)(row0 + ai * HALF + m * 16) * ldc + col0;
#pragma unroll
                for (int bj = 0; bj < 2; ++bj) { const f32x4 v0 = acc[ai][bj][m][0], v1 = acc[ai][bj][m][1];
                    u32x4 w; w.x = cvt_pk_bf16(v0[0], v0[1]); w.y = cvt_pk_bf16(v0[2], v0[3]); w.z = cvt_pk_bf16(v1[0], v1[1]); w.w = cvt_pk_bf16(v1[2], v1[3]);
                    *(u32x4*)(rowp + bj * HALF) = w; } }
        if (u.pn == pn_low && wc == 0) {
#pragma unroll
            for (int ai = 0; ai < 2; ++ai)
#pragma unroll
                for (int m = 0; m < 4; ++m) { float* ap = alow + (size_t)(row0 + ai * HALF + m * 16) * 32 + 8 * fq;
                    *(f32x4*)(ap) = acc[ai][0][m][0]; *(f32x4*)(ap + 4) = acc[ai][0][m][1]; }
        }
    }
};
struct EpiResid {
    static constexpr bool PERM = false, AFTER_DRAIN = false;
    const float* base; float* out; const float* gate; int gstride; int rows_per_b; int ldc;
    __device__ __forceinline__ void operator()(const f32x4 (&acc)[2][2][4][2], const Unit& u, int wr, int wc, int fr, int fq) const {
        const int row0 = u.pm * BM + wr * 64 + fr, col0 = u.pn * BM + wc * 32 + 4 * fq;
        const int b = (u.pm * BM) / rows_per_b;
        f32x4 gv[2][2];
#pragma unroll
        for (int bj = 0; bj < 2; ++bj)
#pragma unroll
            for (int n = 0; n < 2; ++n) gv[bj][n] = *(const f32x4*)(gate + (size_t)b * gstride + col0 + bj * HALF + n * 16);
#pragma unroll
        for (int ai = 0; ai < 2; ++ai)
#pragma unroll
            for (int m = 0; m < 4; ++m) { const size_t off = (size_t)(row0 + ai * HALF + m * 16) * ldc + col0;
#pragma unroll
                for (int bj = 0; bj < 2; ++bj)
#pragma unroll
                    for (int n = 0; n < 2; ++n) { const f32x4 bs = *(const f32x4*)(base + off + bj * HALF + n * 16);
                        *(f32x4*)(out + off + bj * HALF + n * 16) = bs + gv[bj][n] * acc[ai][bj][m][n]; } }
    }
};


__device__ __forceinline__ float dpp_shr4(float v) { return __builtin_bit_cast(float, __builtin_amdgcn_update_dpp(0, __builtin_bit_cast(int, v), 0x114, 0xF, 0xF, true)); }
__device__ __forceinline__ float dpp_shl4(float v) { return __builtin_bit_cast(float, __builtin_amdgcn_update_dpp(0, __builtin_bit_cast(int, v), 0x104, 0xF, 0xF, true)); }
__device__ __forceinline__ unsigned cvtpk2(float lo, float hi) { typedef float f2 __attribute__((ext_vector_type(2))); typedef __bf16 b2 __attribute__((ext_vector_type(2))); const f2 v = {lo, hi}; return __builtin_bit_cast(unsigned, __builtin_convertvector(v, b2)); }
struct EpiConvGate {
    static constexpr bool PERM = true, AFTER_DRAIN = false;
    bf16_t* ACT; int ldact; const float* cw; const float* cb; int nup;
    __device__ __forceinline__ void operator()(const f32x4 (&acc)[2][2][4][2], const Unit& u, int wr, int wc, int fr, int fq) const {
        const int b = u.pm >> 3, u8 = u.pm & 7, hid = nup >> 1;
        const int ch0 = u.pn * 128 + wc * 32 + 8 * fq;
        bf16_t* obase = ACT + ((size_t)b * 2048 + (size_t)(8 * (fr >> 2)) * 64 + 8 * u8 + 4 * wr + (fr & 3)) * ldact + ch0;
        unsigned pk[8][2];
#pragma unroll
        for (int n = 0; n < 2; ++n) {
            const int ch = ch0 + 4 * n;
            const f32x4 wa0 = *(const f32x4*)(cw + ch), wa1 = *(const f32x4*)(cw + nup + ch), wa2 = *(const f32x4*)(cw + 2 * nup + ch), ba = *(const f32x4*)(cb + ch);
            const f32x4 wg0 = *(const f32x4*)(cw + hid + ch), wg1 = *(const f32x4*)(cw + nup + hid + ch), wg2 = *(const f32x4*)(cw + 2 * nup + hid + ch), bg = *(const f32x4*)(cb + hid + ch);
            f32x4 ap0, an7, gp0, gn7;
#pragma unroll
            for (int e = 0; e < 4; ++e) { ap0[e] = dpp_shr4(acc[1][0][3][n][e]); an7[e] = dpp_shl4(acc[0][0][0][n][e]); gp0[e] = dpp_shr4(acc[1][1][3][n][e]); gn7[e] = dpp_shl4(acc[0][1][0][n][e]); }
#pragma unroll
            for (int e3 = 0; e3 < 8; ++e3) {
                const f32x4 ua = acc[e3 >> 2][0][e3 & 3][n], ug = acc[e3 >> 2][1][e3 & 3][n];
                const f32x4 ap = e3 ? acc[(e3 - 1 + 8) % 8 >> 2][0][(e3 - 1 + 8) % 8 & 3][n] : ap0, an = e3 < 7 ? acc[(e3 + 1) % 8 >> 2][0][(e3 + 1) % 8 & 3][n] : an7;
                const f32x4 gp = e3 ? acc[(e3 - 1 + 8) % 8 >> 2][1][(e3 - 1 + 8) % 8 & 3][n] : gp0, gn = e3 < 7 ? acc[(e3 + 1) % 8 >> 2][1][(e3 + 1) % 8 & 3][n] : gn7;
                const f32x4 A = ap * wa0 + ua * wa1 + an * wa2 + ba;
                const f32x4 G = gp * wg0 + ug * wg1 + gn * wg2 + bg;
                f32x4 r;
#pragma unroll
                for (int e = 0; e < 4; ++e) r[e] = A[e] * G[e] * __builtin_amdgcn_rcpf(1.0f + __expf(-G[e]));
                if (n == 0) { pk[e3][0] = cvtpk2(r[0], r[1]); pk[e3][1] = cvtpk2(r[2], r[3]); }
                else { u32x4 w; w.x = pk[e3][0]; w.y = pk[e3][1]; w.z = cvtpk2(r[0], r[1]); w.w = cvtpk2(r[2], r[3]); *(u32x4*)(obase + (size_t)(e3 * 64) * ldact) = w; }
            }
        }
    }
};
template <class Epi, class Sched, bool ALIGN_EPI = false, bool SP2 = false>
__device__ __forceinline__ void gemm_phase(PG8_LAS unsigned char* lds, const Gemm g, const Sched& S, const Epi& E) {
    const int tid = threadIdx.x, wid = __builtin_amdgcn_readfirstlane(tid >> 6), lane = tid & 63, wr = wid >> 2, wc = wid & 3, fr = lane & 15, fq = lane >> 4;
    const int K = g.K, nt = K / BK;
    unsigned voffA[2], voffB[2];
#pragma unroll
    for (int i = 0; i < 2; ++i) { int R, C; stage_rc(tid * 16 + i * 8192, R, C); const int Rb = Epi::PERM ? ((R & ~31) + perm32(R & 31)) : R;
        voffA[i] = (unsigned)(R * K + C) * 2u; voffB[i] = (unsigned)(Rb * K + C) * 2u; }
    const size_t kstep = (size_t)(BK * 2);
    const size_t hstep = (size_t)HALF * K * 2;
    const size_t tstep = 2 * hstep;
    const unsigned ldsw = (unsigned)wid * 1024u;
    const int aoff = lds_byte(wr * 64 + fr, fq * 8), boff = lds_byte(wc * 32 + fr, fq * 8);
#define PG8_SA(b, h) (((b) * 2 + (h)) * HTB)
#define PG8_SB(b, h) ((4 + (b) * 2 + (h)) * HTB)
#define PG8_STAGE(bufoff, gbase, voff) do { _Pragma("unroll") for (int _i = 0; _i < 2; ++_i) \
        __builtin_amdgcn_global_load_lds((const unsigned*)((const char*)(gbase) + (voff)[_i]), (PG8_LAS unsigned*)(lds + (bufoff) + ldsw + _i * 8192), 16, 0, 0); } while (0)
#define PG8_LDA(dst, b, h) do { _Pragma("unroll") for (int m = 0; m < 4; ++m) _Pragma("unroll") for (int k = 0; k < 2; ++k) dst[m][k] = *(const PG8_LAS bf16x8*)(lds + PG8_SA(b, h) + aoff + m * 2048 + k * 1024); } while (0)
#define PG8_LDB(dst, b, h) do { _Pragma("unroll") for (int n = 0; n < 2; ++n) _Pragma("unroll") for (int k = 0; k < 2; ++k) dst[n][k] = *(const PG8_LAS bf16x8*)(lds + PG8_SB(b, h) + boff + n * 2048 + k * 1024); } while (0)
#define PG8_MMA(ai, bj, At, Bt) do { __builtin_amdgcn_s_setprio(1); _Pragma("unroll") for (int m = 0; m < 4; ++m) _Pragma("unroll") for (int n = 0; n < 2; ++n) _Pragma("unroll") for (int k = 0; k < 2; ++k) \
        acc[ai][bj][m][n] = __builtin_amdgcn_mfma_f32_16x16x32_bf16(Bt[n][k], At[m][k], acc[ai][bj][m][n], 0, 0, 0); __builtin_amdgcn_s_setprio(0); } while (0)
#define PG8_WAIT_V(n) asm volatile("s_waitcnt vmcnt(" #n ")" ::: "memory")
#define PG8_WAIT_L(n) asm volatile("s_waitcnt lgkmcnt(" #n ")" ::: "memory")
#define PG8_BAR __builtin_amdgcn_s_barrier()
#define PG8_SCHED __builtin_amdgcn_sched_barrier(0)
    Unit cur, nxt; int ui = 0;
    if (!S.next(0, cur)) return;
    f32x4 acc[2][2][4][2];
#pragma unroll
    for (int a = 0; a < 2; ++a)
#pragma unroll
        for (int b = 0; b < 2; ++b)
#pragma unroll
            for (int m = 0; m < 4; ++m)
#pragma unroll
                for (int n = 0; n < 2; ++n) acc[a][b][m][n] = (f32x4){0.f, 0.f, 0.f, 0.f};
    bf16x8 At[4][2], B0[2][2], B1[2][2];
    const char* cA = (const char*)g.A + (size_t)cur.pm * tstep; const char* cB = (const char*)g.Bt + (size_t)cur.pn * tstep;
    S.a_ready(cur);
    if constexpr (SP2) {
        PG8_STAGE(PG8_SB(0, 0), cB, voffB); PG8_STAGE(PG8_SB(0, 1), cB + hstep, voffB); PG8_STAGE(PG8_SA(0, 0), cA, voffA); PG8_STAGE(PG8_SA(0, 1), cA + hstep, voffA);
        if (wr == 1) PG8_BAR;
        PG8_WAIT_V(2); PG8_BAR;
        PG8_STAGE(PG8_SB(1, 0), cB + kstep, voffB); PG8_STAGE(PG8_SA(1, 0), cA + kstep, voffA); PG8_STAGE(PG8_SB(1, 1), cB + hstep + kstep, voffB);
        PG8_WAIT_V(6); PG8_BAR;
    } else {
        PG8_STAGE(PG8_SB(0, 0), cB, voffB); PG8_STAGE(PG8_SA(0, 0), cA, voffA); PG8_STAGE(PG8_SB(0, 1), cB + hstep, voffB); PG8_STAGE(PG8_SA(0, 1), cA + hstep, voffA);
        if (wr == 1) PG8_BAR;
        PG8_WAIT_V(4); PG8_BAR;
        PG8_STAGE(PG8_SB(1, 0), cB + kstep, voffB); PG8_STAGE(PG8_SA(1, 0), cA + kstep, voffA); PG8_STAGE(PG8_SB(1, 1), cB + hstep + kstep, voffB);
        PG8_WAIT_V(6); PG8_BAR;
    }
    for (;;) {
        const bool has_next = S.next(ui + 1, nxt);
        const char* nA = has_next ? (const char*)g.A + (size_t)nxt.pm * tstep : cA; const char* nB = has_next ? (const char*)g.Bt + (size_t)nxt.pn * tstep : cB;
        for (int t = 0; t < nt; t += 2) {
            const bool last = (t == nt - 2);
            const char* a1 = cA + (size_t)(t + 1) * kstep;
            const char* a2 = last ? nA : cA + (size_t)(t + 2) * kstep; const char* b2 = last ? nB : cB + (size_t)(t + 2) * kstep;
            const char* a3 = a2 + kstep; const char* b3 = b2 + kstep;
            if (last && has_next) S.a_ready(nxt);
            if constexpr (SP2) {
            PG8_LDB(B0, 0, 0); PG8_LDB(B1, 0, 1); PG8_SCHED; PG8_LDA(At, 0, 0); PG8_STAGE(PG8_SA(1, 1), a1 + hstep, voffA);
            PG8_WAIT_V(8); PG8_WAIT_L(0); PG8_BAR; PG8_MMA(0, 0, At, B0); PG8_MMA(0, 1, At, B1); PG8_BAR; PG8_SCHED;
            PG8_LDA(At, 0, 1); PG8_STAGE(PG8_SB(0, 0), b2, voffB); PG8_STAGE(PG8_SB(0, 1), b2 + hstep, voffB); PG8_STAGE(PG8_SA(0, 0), a2, voffA);
            PG8_WAIT_V(8); PG8_WAIT_L(0); PG8_BAR; PG8_MMA(1, 0, At, B0); PG8_MMA(1, 1, At, B1); PG8_BAR; PG8_SCHED;
            PG8_LDB(B0, 1, 0); PG8_LDB(B1, 1, 1); PG8_SCHED; PG8_LDA(At, 1, 0); PG8_STAGE(PG8_SA(0, 1), a2 + hstep, voffA);
            PG8_WAIT_V(8); PG8_WAIT_L(0); PG8_BAR; PG8_MMA(0, 0, At, B0); PG8_MMA(0, 1, At, B1); PG8_BAR; PG8_SCHED;
            PG8_LDA(At, 1, 1); PG8_STAGE(PG8_SB(1, 0), b3, voffB); PG8_STAGE(PG8_SB(1, 1), b3 + hstep, voffB); PG8_STAGE(PG8_SA(1, 0), a3, voffA);
            PG8_WAIT_V(8); PG8_WAIT_L(0); PG8_BAR; PG8_MMA(1, 0, At, B0); PG8_MMA(1, 1, At, B1); PG8_BAR; PG8_SCHED;
            } else {
            PG8_LDB(B0, 0, 0); PG8_SCHED; PG8_LDA(At, 0, 0); PG8_STAGE(PG8_SA(1, 1), a1 + hstep, voffA);
            PG8_WAIT_L(8); PG8_BAR; PG8_WAIT_L(0); PG8_MMA(0, 0, At, B0); PG8_BAR; PG8_SCHED;
            PG8_LDB(B1, 0, 1); PG8_STAGE(PG8_SB(0, 0), b2, voffB);
            PG8_BAR; PG8_WAIT_L(0); PG8_MMA(0, 1, At, B1); PG8_BAR;
            PG8_LDA(At, 0, 1); PG8_STAGE(PG8_SA(0, 0), a2, voffA);
            PG8_BAR; PG8_WAIT_L(0); PG8_MMA(1, 0, At, B0); PG8_BAR; PG8_SCHED;
            PG8_STAGE(PG8_SB(0, 1), b2 + hstep, voffB);
            PG8_WAIT_V(6); PG8_BAR; PG8_MMA(1, 1, At, B1); PG8_BAR;
            PG8_LDB(B0, 1, 0); PG8_SCHED; PG8_LDA(At, 1, 0); PG8_STAGE(PG8_SA(0, 1), a2 + hstep, voffA);
            PG8_WAIT_L(8); PG8_BAR; PG8_WAIT_L(0); PG8_MMA(0, 0, At, B0); PG8_BAR; PG8_SCHED;
            PG8_LDB(B1, 1, 1); PG8_STAGE(PG8_SB(1, 0), b3, voffB);
            PG8_BAR; PG8_WAIT_L(0); PG8_MMA(0, 1, At, B1); PG8_BAR;
            PG8_LDA(At, 1, 1); PG8_STAGE(PG8_SA(1, 0), a3, voffA);
            PG8_BAR; PG8_WAIT_L(0); PG8_MMA(1, 0, At, B0); PG8_BAR; PG8_SCHED;
            PG8_STAGE(PG8_SB(1, 1), b3 + hstep, voffB);
            PG8_WAIT_V(6); PG8_BAR; PG8_MMA(1, 1, At, B1); PG8_BAR;
            }
        }
        if constexpr (ALIGN_EPI) { if (wr == 0) PG8_BAR; }
        if constexpr (!Epi::AFTER_DRAIN) { E(acc, cur, wr, wc, fr, fq); S.done(cur); }
        if (!has_next) break;
#pragma unroll
        for (int a = 0; a < 2; ++a)
#pragma unroll
            for (int b = 0; b < 2; ++b)
#pragma unroll
                for (int m = 0; m < 4; ++m)
#pragma unroll
                    for (int n = 0; n < 2; ++n) acc[a][b][m][n] = (f32x4){0.f, 0.f, 0.f, 0.f};
        cur = nxt; cA = nA; cB = nB; ++ui;
        if constexpr (ALIGN_EPI) { if (wr == 1) PG8_BAR; }
    }
    PG8_WAIT_V(0);
    if constexpr (!ALIGN_EPI) { if (wr == 0) PG8_BAR; }
    PG8_BAR;
    if constexpr (Epi::AFTER_DRAIN) { E.fused(acc, cur, wr, wc, fr, fq, lds, wid, lane); S.done(cur); }
#undef PG8_SA
#undef PG8_SB
#undef PG8_STAGE
#undef PG8_LDA
#undef PG8_LDB
#undef PG8_MMA
#undef PG8_WAIT_V
#undef PG8_WAIT_L
#undef PG8_BAR
#undef PG8_SCHED
}
}

#define LAS __attribute__((address_space(3)))
typedef unsigned short bf16;
typedef unsigned v4u __attribute__((ext_vector_type(4)));
typedef unsigned v2u __attribute__((ext_vector_type(2)));
typedef float f32x4 __attribute__((ext_vector_type(4)));
constexpr int D = 1024, BATCH = 16, SEQ = 2048, NTOK = BATCH * SEQ, CTXL = 256, NCTX = BATCH * CTXL, MROWS = NTOK + NCTX;
constexpr int GIN = 3104, GINP = 3328, KD = 512, VD = 1024, RANK = 16, HK = 128, HV = 256;
constexpr int FH = 2560, FUP = 5120, NMOD = 6144, MODROWS = 17;
constexpr float EPS = 1e-6f;
constexpr int NWAVES = 8, NTHREADS = 512;
constexpr int LDS_BYTES = 159744;
constexpr int LDS_MISC = LDS_BYTES - 256;
constexpr int CW_BAR = 4096;
enum { I_X = 0, I_C, I_CTX, I_CCTX, I_ADAW, I_ADAB, I_NMIX, I_NFFN, I_GWIN, I_GWA2, I_GBA, I_GHN, I_GWOUT, I_SCWIN, I_SCCW, I_SCWOUT, I_FUP, I_FCW, I_FCB, I_FDN, I_FINAL, N_IN };
constexpr size_t MiB = 1u << 20;
constexpr size_t WS_CTL = 0, CTL_ZERO_BYTES = 1 * MiB;
constexpr size_t WS_MOD = 1 * MiB;
constexpr size_t WS_WIN = 2 * MiB;
constexpr size_t WS_WOUT = 9 * MiB;
constexpr size_t WS_SCIN = 11 * MiB;
constexpr size_t WS_SCOUT = 17 * MiB;
constexpr size_t WS_WUP = 19 * MiB;
constexpr size_t WS_WDN = 39 * MiB;
constexpr size_t WS_ALOW = 49 * MiB;
constexpr size_t WS_HN = 56 * MiB;
constexpr size_t WS_PROJ = 128 * MiB;
constexpr size_t WS_OF = 362 * MiB, WS_OB = 426 * MiB;
constexpr size_t WS_U = 128 * MiB;
constexpr size_t WS_ACT = 288 * MiB;
constexpr size_t WS_BCV = 128 * MiB;
constexpr size_t WS_END = 490 * MiB;

__device__ __forceinline__ unsigned f2bf(float f) { unsigned u = __builtin_bit_cast(unsigned, f); return (u + 0x7fffu + ((u >> 16) & 1u)) >> 16; }
__device__ __forceinline__ unsigned pk2(float lo, float hi) { return f2bf(lo) | (f2bf(hi) << 16); }
__device__ __forceinline__ float bflo(unsigned w) { return __builtin_bit_cast(float, w << 16); }
__device__ __forceinline__ float bfhi(unsigned w) { return __builtin_bit_cast(float, w & 0xffff0000u); }
__device__ __forceinline__ float bf2f(bf16 h) { return __builtin_bit_cast(float, ((unsigned)h) << 16); }
__device__ __forceinline__ float silu_f(float v) { return v / (1.0f + __expf(-v)); }
__device__ __forceinline__ float wave_sum(float v) {
#pragma unroll
    for (int o = 1; o < 64; o <<= 1) v += __shfl_xor(v, o);
    return v;
}
__device__ __forceinline__ void unpack8(const v4u w, float (&f)[8]) { f[0] = bflo(w.x); f[1] = bfhi(w.x); f[2] = bflo(w.y); f[3] = bfhi(w.y); f[4] = bflo(w.z); f[5] = bfhi(w.z); f[6] = bflo(w.w); f[7] = bfhi(w.w); }
__device__ __forceinline__ v4u pack8(const float (&f)[8]) { v4u w; w.x = pk2(f[0], f[1]); w.y = pk2(f[2], f[3]); w.z = pk2(f[4], f[5]); w.w = pk2(f[6], f[7]); return w; }

struct Params { const float* in[N_IN]; float* out; unsigned char* ws; int ph_lo, ph_hi; };

__device__ __forceinline__ void transpose_item(const float* W, int K, int N, bf16* WT, int k0, int n0, int rowbase, LAS float* scr, int lane) {
#pragma unroll 8
    for (int i = 0; i < 32; ++i) { const int kk = 2 * i + (lane >> 5); scr[kk * 33 + (lane & 31)] = W[(size_t)(k0 + kk) * N + n0 + (lane & 31)]; }
    asm volatile("s_waitcnt lgkmcnt(0)" ::: "memory");
    const int c = lane & 7;
#pragma unroll
    for (int j = 0; j < 4; ++j) { const int n = (lane >> 3) + 8 * j; const LAS float* s = scr + (8 * c) * 33 + n;
        v4u o; o.x = pk2(s[0 * 33], s[1 * 33]); o.y = pk2(s[2 * 33], s[3 * 33]); o.z = pk2(s[4 * 33], s[5 * 33]); o.w = pk2(s[6 * 33], s[7 * 33]);
        *(v4u*)(WT + (size_t)(rowbase + n) * K + k0 + 8 * c) = o; }
    asm volatile("s_waitcnt lgkmcnt(0)" ::: "memory");
}
__device__ __forceinline__ int uprow(int n) { return n < FH ? ((n >> 7) * 256 + (n & 127)) : ((((n - FH) >> 7) * 256) + 128 + ((n - FH) & 127)); }

__device__ __forceinline__ void phase_prep(const Params& P, LAS unsigned char* lds, int tid, int wave, int lane) {
    const int G = gridDim.x, gw = blockIdx.x * NWAVES + wave, NGW = G * NWAVES;
    unsigned char* ws = P.ws;
    LAS float* scr = (LAS float*)(lds + wave * 16384);
    constexpr int I_WIN = (D / 64) * (GIN / 32), I_WOUT = (D / 64) * (D / 32), I_SCIN = (D / 64) * (3 * D / 32), I_UP = (D / 64) * (FUP / 32), I_DN = (FH / 64) * (D / 32);
    constexpr int NITEMS = I_WIN + 2 * I_WOUT + I_SCIN + 2 * I_UP + 2 * I_DN;
    for (int it = gw; it < NITEMS; it += NGW) {
        int r = it;
        if (r < I_WIN) { const int nb = GIN / 32, kb = r / nb, n0 = 32 * (r % nb); transpose_item(P.in[I_GWIN], D, GIN, (bf16*)(ws + WS_WIN), 64 * kb, n0, n0, scr, lane); continue; } r -= I_WIN;
        if (r < I_WOUT) { const int nb = D / 32, kb = r / nb, n0 = 32 * (r % nb); transpose_item(P.in[I_GWOUT], D, D, (bf16*)(ws + WS_WOUT), 64 * kb, n0, n0, scr, lane); continue; } r -= I_WOUT;
        if (r < I_WOUT) { const int nb = D / 32, kb = r / nb, n0 = 32 * (r % nb); transpose_item(P.in[I_SCWOUT], D, D, (bf16*)(ws + WS_SCOUT), 64 * kb, n0, n0, scr, lane); continue; } r -= I_WOUT;
        if (r < I_SCIN) { const int nb = 3 * D / 32, kb = r / nb, n0 = 32 * (r % nb); transpose_item(P.in[I_SCWIN], D, 3 * D, (bf16*)(ws + WS_SCIN), 64 * kb, n0, n0, scr, lane); continue; } r -= I_SCIN;
        if (r < 2 * I_UP) { const int l = r / I_UP; r -= l * I_UP; const int nb = FUP / 32, kb = r / nb, n0 = 32 * (r % nb);
            transpose_item(P.in[I_FUP] + (size_t)l * D * FUP, D, FUP, (bf16*)(ws + WS_WUP) + (size_t)l * FUP * D, 64 * kb, n0, uprow(n0), scr, lane); continue; } r -= 2 * I_UP;
        { const int l = r / I_DN; r -= l * I_DN; const int nb = D / 32, kb = r / nb, n0 = 32 * (r % nb);
            transpose_item(P.in[I_FDN] + (size_t)l * FH * D, FH, D, (bf16*)(ws + WS_WDN) + (size_t)l * D * FH, 64 * kb, n0, n0, scr, lane); }
    }
    { v4u* z = (v4u*)((bf16*)(ws + WS_WIN) + (size_t)GIN * D); const int n16 = (GINP - GIN) * D * 2 / 16;
      for (int i = blockIdx.x * NTHREADS + tid; i < n16; i += G * NTHREADS) z[i] = (v4u){0u, 0u, 0u, 0u}; }
    __syncthreads();
    if ((int)blockIdx.x < 192) {
        LAS float* s = (LAS float*)lds;
        LAS float* red = s + MODROWS * D;
        for (int i = tid; i < MODROWS * D; i += NTHREADS) { const int b = i >> 10, k = i & 1023; const float cv = b < 16 ? P.in[I_C][b * D + k] : P.in[I_CCTX][k]; s[i] = silu_f(cv); }
        __syncthreads();
        float* MOD = (float*)(ws + WS_MOD);
        for (int it = blockIdx.x; it < 192; it += G) {
            const int layer = it / 96, cb = it % 96, col = cb * 64 + lane;
            const float* W = P.in[I_ADAW] + (size_t)layer * D * NMOD;
            float acc[MODROWS];
#pragma unroll
            for (int b = 0; b < MODROWS; ++b) acc[b] = 0.f;
            for (int k = wave * 128; k < wave * 128 + 128; k += 4) {
                const float w0 = W[(size_t)(k + 0) * NMOD + col], w1 = W[(size_t)(k + 1) * NMOD + col], w2 = W[(size_t)(k + 2) * NMOD + col], w3 = W[(size_t)(k + 3) * NMOD + col];
#pragma unroll
                for (int b = 0; b < MODROWS; ++b) { const f32x4 sv = *(const LAS f32x4*)(s + b * D + k); acc[b] += sv[0] * w0 + sv[1] * w1 + sv[2] * w2 + sv[3] * w3; }
            }
#pragma unroll
            for (int b = 0; b < MODROWS; ++b) red[(wave * MODROWS + b) * 64 + lane] = acc[b];
            __syncthreads();
            for (int o = tid; o < MODROWS * 64; o += NTHREADS) { const int b = o >> 6, l = o & 63; float sum = 0.f;
#pragma unroll
                for (int w = 0; w < NWAVES; ++w) sum += red[(w * MODROWS + b) * 64 + l];
                MOD[(size_t)(layer * MODROWS + b) * NMOD + cb * 64 + l] = sum + P.in[I_ADAB][layer * NMOD + cb * 64 + l]; }
            __syncthreads();
        }
    }
}

__device__ __forceinline__ int ffn_perm_pos(int t) { const int b = t >> 11, r = (t >> 6) & 31, c = t & 63; return (b * 8 + (c >> 3)) * 256 + 128 * ((r >> 2) & 1) + 64 * ((c & 7) >> 2) + 16 * (r & 3) + 4 * (r >> 3) + (c & 3); }
template <bool PERMROWS>
__device__ __forceinline__ void modulate_rows(const float* src, int nrows, int rows_per_b, int bfix, const float* gain, const float* mod, int shift_i, int scale_i, bf16* dst, int gw, int NGW, int lane) {
    for (int row = gw; row < nrows; row += NGW) {
        const int b = bfix >= 0 ? bfix : row / rows_per_b;
        const f32x4* xr = (const f32x4*)(src + (size_t)row * D) + lane;
        f32x4 v[4]; float ss = 0.f;
#pragma unroll
        for (int j = 0; j < 4; ++j) { v[j] = xr[64 * j]; ss += (v[j][0] * v[j][0] + v[j][1] * v[j][1]) + (v[j][2] * v[j][2] + v[j][3] * v[j][3]); }
        const float rstd = 1.0f / sqrtf(wave_sum(ss) * (1.0f / D) + EPS);
        const float* sh = mod + (size_t)b * NMOD + shift_i * D; const float* sc = mod + (size_t)b * NMOD + scale_i * D;
        v2u* o8 = (v2u*)(dst + (size_t)(PERMROWS ? ffn_perm_pos(row) : row) * D) + lane;
#pragma unroll
        for (int j = 0; j < 4; ++j) { const int idx = 4 * lane + 256 * j; const f32x4 g = *(const f32x4*)(gain + idx), s4 = *(const f32x4*)(sh + idx), c4 = *(const f32x4*)(sc + idx);
            const f32x4 y = ((v[j] * rstd) * g) * (c4 + 1.0f) + s4; v2u w; w.x = pk2(y[0], y[1]); w.y = pk2(y[2], y[3]); o8[64 * j] = w; }
    }
}
__device__ __forceinline__ void final_norm_rows(float* h, const float* gain, int gw, int NGW, int lane) {
    for (int row = gw; row < NTOK; row += NGW) {
        f32x4* xr = (f32x4*)(h + (size_t)row * D) + lane;
        f32x4 v[4]; float ss = 0.f;
#pragma unroll
        for (int j = 0; j < 4; ++j) { v[j] = xr[64 * j]; ss += (v[j][0] * v[j][0] + v[j][1] * v[j][1]) + (v[j][2] * v[j][2] + v[j][3] * v[j][3]); }
        const float rstd = 1.0f / sqrtf(wave_sum(ss) * (1.0f / D) + EPS);
#pragma unroll
        for (int j = 0; j < 4; ++j) { const f32x4 g = *(const f32x4*)(gain + 4 * lane + 256 * j); xr[64 * j] = (v[j] * rstd) * g; }
    }
}

__device__ __forceinline__ void phase_scan_naive(const Params& P, LAS unsigned char* lds, int tid) {
    const int half = tid >> 8, t8 = tid & 255;
    LAS float* buf = (LAS float*)lds + half * 768;
    const bf16* PROJ = (const bf16*)(P.ws + WS_PROJ); const float* ALOW = (const float*)(P.ws + WS_ALOW);
    for (int it0 = blockIdx.x * 2; it0 < BATCH * 4 * 2; it0 += gridDim.x * 2) {
        const int item = it0 + half, b = item >> 3, h = (item >> 1) & 3, dir = item & 1;
        bf16* O = (bf16*)(P.ws + (dir ? WS_OB : WS_OF));
        float S[HK];
#pragma unroll
        for (int c = 0; c < HK; ++c) S[c] = 0.f;
        float w2[RANK], ba = 0.f;
#pragma unroll
        for (int r = 0; r < RANK; ++r) w2[r] = 0.f;
        if (t8 < HK) {
#pragma unroll
            for (int r = 0; r < RANK; ++r) w2[r] = P.in[I_GWA2][(dir * RANK + r) * KD + h * HK + t8];
            ba = P.in[I_GBA][dir * KD + h * HK + t8]; }
        for (int step = 0; step < CTXL + SEQ; ++step) {
            const bool isctx = step < CTXL; const int idx = isctx ? step : step - CTXL, n = isctx ? CTXL : SEQ, pos = dir ? n - 1 - idx : idx;
            const size_t row = isctx ? (size_t)NTOK + b * CTXL + pos : (size_t)b * SEQ + pos;
            LAS float* cur = buf + (step & 1) * 384;
            const bf16* pr = PROJ + row * GINP;
            if (t8 < HK) {
                const float q = bf2f(pr[h * HK + t8]) * 0.08838834764831845f, k = bf2f(pr[KD + h * HK + t8]);
                const float* al = ALOW + row * 32 + dir * RANK; float z = ba;
#pragma unroll
                for (int r = 0; r < RANK; ++r) z += al[r] * w2[r];
                const float ls = fminf(z, 0.f) - log1pf(expf(-fabsf(z)));
                cur[t8] = q; cur[128 + t8] = k; cur[256 + t8] = expf(ls * (1.0f / 16.0f));
            }
            const float v = bf2f(pr[2 * KD + h * HV + t8]);
            __syncthreads();
            float o = 0.f;
#pragma unroll
            for (int c = 0; c < HK; c += 4) { const f32x4 q4 = *(const LAS f32x4*)(cur + c), k4 = *(const LAS f32x4*)(cur + 128 + c), a4 = *(const LAS f32x4*)(cur + 256 + c);
#pragma unroll
                for (int j = 0; j < 4; ++j) { S[c + j] = a4[j] * S[c + j] + k4[j] * v; o += q4[j] * S[c + j]; } }
            if (!isctx) O[row * VD + h * HV + t8] = (bf16)f2bf(o);
        }
    }
}

__device__ __forceinline__ void phase_gate(const Params& P, int gw, int NGW, int lane) {
    const bf16* OF = (const bf16*)(P.ws + WS_OF); const bf16* OB = (const bf16*)(P.ws + WS_OB); const bf16* PROJ = (const bf16*)(P.ws + WS_PROJ); bf16* A = (bf16*)(P.ws + WS_HN);
    const float* hg = P.in[I_GHN] + ((16 * lane) & 255);
    float hgv[16];
#pragma unroll
    for (int i = 0; i < 16; ++i) hgv[i] = hg[i];
    for (int row = gw; row < NTOK; row += NGW) {
        const v4u* pf = (const v4u*)(OF + (size_t)row * VD + 16 * lane); const v4u* pb = (const v4u*)(OB + (size_t)row * VD + 16 * lane); const v4u* pg = (const v4u*)(PROJ + (size_t)row * GINP + 2 * KD + VD + 16 * lane);
        float o[16], t[8], g[16];
        unpack8(pf[0], t);
#pragma unroll
        for (int i = 0; i < 8; ++i) o[i] = t[i];
        unpack8(pf[1], t);
#pragma unroll
        for (int i = 0; i < 8; ++i) o[8 + i] = t[i];
        unpack8(pb[0], t);
#pragma unroll
        for (int i = 0; i < 8; ++i) o[i] += t[i];
        unpack8(pb[1], t);
#pragma unroll
        for (int i = 0; i < 8; ++i) o[8 + i] += t[i];
        unpack8(pg[0], t);
#pragma unroll
        for (int i = 0; i < 8; ++i) g[i] = t[i];
        unpack8(pg[1], t);
#pragma unroll
        for (int i = 0; i < 8; ++i) g[8 + i] = t[i];
        float ss = 0.f;
#pragma unroll
        for (int i = 0; i < 16; ++i) ss += o[i] * o[i];
        ss += __shfl_xor(ss, 1); ss += __shfl_xor(ss, 2); ss += __shfl_xor(ss, 4); ss += __shfl_xor(ss, 8);
        const float rstd = 1.0f / sqrtf(ss * (1.0f / HV) + EPS);
        float r0[8], r1[8];
#pragma unroll
        for (int i = 0; i < 8; ++i) { r0[i] = ((o[i] * rstd) * hgv[i]) * silu_f(g[i]); r1[i] = ((o[8 + i] * rstd) * hgv[8 + i]) * silu_f(g[8 + i]); }
        v4u* pa = (v4u*)(A + (size_t)row * D + 16 * lane); pa[0] = pack8(r0); pa[1] = pack8(r1);
    }
}

__device__ __forceinline__ void phase_convgate(const Params& P, int layer, int half, int gtid, int NT) {
    const bf16* U = (const bf16*)(P.ws + WS_U); bf16* ACT = (bf16*)(P.ws + WS_ACT);
    const float* cw = P.in[I_FCW] + (size_t)layer * 3 * FUP; const float* cb = P.in[I_FCB] + (size_t)layer * FUP;
    const int NITEM = NTOK * 160;
    for (int it = gtid; it < NITEM; it += NT) {
        const int t = it / 160, cg8 = it % 160, pnl = cg8 >> 4, j = (cg8 & 15) * 8, ch = (half * 10 + pnl) * 128 + j;
        const int gr = (t & (SEQ - 1)) >> 6;
        const bf16* ua = U + (size_t)t * FH + pnl * 256 + j; const bf16* ug = ua + 128;
        float a[8], g[8], tmp[8];
#pragma unroll
        for (int i = 0; i < 8; ++i) { a[i] = cb[ch + i]; g[i] = cb[FH + ch + i]; }
#pragma unroll
        for (int tap = 0; tap < 3; ++tap) {
            const int rr = gr + tap - 1; if (rr < 0 || rr > 31) continue;
            const long off = (long)(tap - 1) * 64 * FH;
            unpack8(*(const v4u*)(ua + off), tmp);
#pragma unroll
            for (int i = 0; i < 8; ++i) a[i] += tmp[i] * cw[tap * FUP + ch + i];
            unpack8(*(const v4u*)(ug + off), tmp);
#pragma unroll
            for (int i = 0; i < 8; ++i) g[i] += tmp[i] * cw[tap * FUP + FH + ch + i];
        }
        float r[8];
#pragma unroll
        for (int i = 0; i < 8; ++i) r[i] = a[i] * silu_f(g[i]);
        *(v4u*)(ACT + (size_t)t * FH + ch) = pack8(r);
    }
}
__device__ __forceinline__ void phase_scconv(const Params& P, int gtid, int NT) {
    const bf16* BCV = (const bf16*)(P.ws + WS_BCV); bf16* A = (bf16*)(P.ws + WS_HN);
    const float* cw = P.in[I_SCCW];
    const int NITEM = NTOK * 128;
    for (int it = gtid; it < NITEM; it += NT) {
        const int t = it >> 7, ch = (it & 127) * 8, col = t & 63;
        const bf16* p = BCV + (size_t)t * (3 * D) + ch;
        float acc[8], bgv[8], c8[8], v8[8];
#pragma unroll
        for (int i = 0; i < 8; ++i) acc[i] = 0.f;
#pragma unroll
        for (int tap = 0; tap < 3; ++tap) {
            const int cc = col + tap - 1; if (cc < 0 || cc > 63) continue;
            const long off = (long)(tap - 1) * 3 * D;
            unpack8(*(const v4u*)(p + off + D), c8); unpack8(*(const v4u*)(p + off + 2 * D), v8);
#pragma unroll
            for (int i = 0; i < 8; ++i) acc[i] += (c8[i] * v8[i]) * cw[tap * D + ch + i];
        }
        unpack8(*(const v4u*)p, bgv);
        float r[8];
#pragma unroll
        for (int i = 0; i < 8; ++i) r[i] = bgv[i] * acc[i];
        *(v4u*)(A + (size_t)t * D + ch) = pack8(r);
    }
}


namespace scn {
typedef short bf16x8 __attribute__((ext_vector_type(8)));
typedef short s16x4 __attribute__((ext_vector_type(4)));
typedef float f32x16 __attribute__((ext_vector_type(16)));
typedef float f32x2 __attribute__((ext_vector_type(2)));
typedef __bf16 bf16x2 __attribute__((ext_vector_type(2)));
constexpr int OFF_Q = 0, OFF_K = 16384, OFF_V = 32768, OFF_AL = 49152, BUF = 53248;
constexpr int OFF_P = 2 * BUF, OFF_TOT = OFF_P + 8192, OFF_EL = OFF_TOT + 4096, OFF_X = OFF_EL + 512, LDS_END = OFF_X + 32768;
__device__ __forceinline__ unsigned offb(unsigned row, unsigned ch) { return 256u * row + 16u * (ch ^ (((row & 3u) << 2) | ((row >> 2) & 3u))); }
__device__ __forceinline__ unsigned offp(unsigned i, unsigned ch) { return 128u * i + 16u * (ch ^ ((i >> 1) & 7u)); }
__device__ __forceinline__ unsigned cvtpk(float lo, float hi) { const f32x2 v = {lo, hi}; return __builtin_bit_cast(unsigned, __builtin_convertvector(v, bf16x2)); }
__device__ __forceinline__ s16x4 trrd(LAS unsigned char* p) { return __builtin_bit_cast(s16x4, __builtin_amdgcn_ds_read_tr16_b64_v4i16((LAS s16x4*)p)); }
__device__ __forceinline__ bf16x8 trfrag(LAS unsigned char* img, int lane, int c, int ks) {
    const unsigned h = lane >> 5, blk = (lane >> 4) & 1, q = (lane & 15) >> 2, p = lane & 3;
    const s16x4 lo = trrd(img + offb(16 * ks + 8 * h + q, 4 * c + 2 * blk + (p >> 1)) + 8 * (p & 1));
    const s16x4 hi = trrd(img + offb(16 * ks + 8 * h + 4 + q, 4 * c + 2 * blk + (p >> 1)) + 8 * (p & 1));
    return __builtin_shufflevector(lo, hi, 0, 1, 2, 3, 4, 5, 6, 7);
}
__device__ __forceinline__ bf16x8 pack_step(const f32x16& x, int s) {
    v4u p; p.x = cvtpk(x[8 * s], x[8 * s + 1]); p.y = cvtpk(x[8 * s + 2], x[8 * s + 3]); p.z = cvtpk(x[8 * s + 4], x[8 * s + 5]); p.w = cvtpk(x[8 * s + 6], x[8 * s + 7]);
    return __builtin_bit_cast(bf16x8, p);
}
#define MFMA32(a, b, c) __builtin_amdgcn_mfma_f32_32x32x16_bf16((a), (b), (c), 0, 0, 0)
#define MFMA16(a, b, c) __builtin_amdgcn_mfma_f32_16x16x32_bf16((a), (b), (c), 0, 0, 0)

__device__ __forceinline__ void phase_scan(const Params& P, LAS unsigned char* lds, int tid, int wave, int lane) {
    const bf16* PROJ = (const bf16*)(P.ws + WS_PROJ); const float* ALOW = (const float*)(P.ws + WS_ALOW);
    const int ch = wave >> 2, dq = wave & 3;
    for (int item = blockIdx.x; item < BATCH * 4 * 2 * 2; item += gridDim.x) {
        const int b = item >> 4, h = (item >> 2) & 3, dir = (item >> 1) & 1, dvh = item & 1;
        bf16* O = (bf16*)(P.ws + (dir ? WS_OB : WS_OF));
        float w2a[RANK], w2b[RANK];
#pragma unroll
        for (int rr = 0; rr < RANK; ++rr) { const f32x2 w = *(const f32x2*)(P.in[I_GWA2] + (size_t)(dir * RANK + rr) * KD + h * HK + 2 * lane); w2a[rr] = w[0]; w2b[rr] = w[1]; }
        const f32x2 bav = *(const f32x2*)(P.in[I_GBA] + dir * KD + h * HK + 2 * lane);
        f32x16 S[2];
#pragma unroll
        for (int i = 0; i < 16; ++i) { S[0][i] = 0.f; S[1][i] = 0.f; }
        v4u rq[2], rk[2], rv[2], ra;
#define SCN_ROW0(s) ((s) < 4 ? (size_t)NTOK + (size_t)b * CTXL + 64 * (dir ? 3 - (s) : (s)) : (size_t)b * SEQ + 64 * (dir ? 31 - ((s) - 4) : ((s) - 4)))
#define SCN_LOAD(s) do { const size_t row0_ = SCN_ROW0(s); _Pragma("unroll") for (int i_ = 0; i_ < 2; ++i_) { const int cx_ = tid + 512 * i_, rw_ = cx_ >> 4, c16_ = cx_ & 15; \
            const bf16* pr_ = PROJ + (row0_ + rw_) * GINP + 8 * c16_; rq[i_] = *(const v4u*)(pr_ + h * HK); rk[i_] = *(const v4u*)(pr_ + KD + h * HK); rv[i_] = *(const v4u*)(pr_ + 2 * KD + h * HV + dvh * 128); } \
            if (tid < 256) ra = *(const v4u*)(ALOW + (row0_ + (tid >> 2)) * 32 + dir * RANK + 4 * (tid & 3)); } while (0)
#define SCN_STORE(bo) do { _Pragma("unroll") for (int i_ = 0; i_ < 2; ++i_) { const int cx_ = tid + 512 * i_, rw_ = cx_ >> 4, c16_ = cx_ & 15; const unsigned o_ = offb(rw_, c16_); \
            *(LAS v4u*)(lds + (bo) + OFF_Q + o_) = rq[i_]; *(LAS v4u*)(lds + (bo) + OFF_K + o_) = rk[i_]; *(LAS v4u*)(lds + (bo) + OFF_V + o_) = rv[i_]; } \
            if (tid < 256) *(LAS v4u*)(lds + (bo) + OFF_AL + tid * 16) = ra; } while (0)
        SCN_LOAD(0); SCN_STORE(0);
        __syncthreads();
        for (int s = 0; s < 36; ++s) {
            const int bo = (s & 1) * BUF; const bool isctx = s < 4;
            LAS unsigned char* Qi = lds + bo + OFF_Q; LAS unsigned char* Ki = lds + bo + OFF_K; LAS unsigned char* Vi = lds + bo + OFF_V;
            const LAS float* AL = (const LAS float*)(lds + bo + OFF_AL);
            LAS float* TOT = (LAS float*)(lds + OFF_TOT); LAS float* EL = (LAS float*)(lds + OFF_EL);
            int lg = lane; asm volatile("" : "+v"(lg));
            float P0[8], P1[8]; float run0 = 0.f, run1 = 0.f;
#pragma unroll
            for (int t = 0; t < 8; ++t) {
                const int j = 8 * wave + t; float z0 = bav[0], z1 = bav[1];
#pragma unroll
                for (int q4 = 0; q4 < 4; ++q4) { const f32x4 a = *(const LAS f32x4*)(AL + j * 16 + 4 * q4);
#pragma unroll
                    for (int e = 0; e < 4; ++e) { z0 += a[e] * w2a[4 * q4 + e]; z1 += a[e] * w2b[4 * q4 + e]; } }
                const float l0 = (fminf(z0, 0.f) - log1pf(expf(-fabsf(z0)))) * 0.0625f, l1 = (fminf(z1, 0.f) - log1pf(expf(-fabsf(z1)))) * 0.0625f;
                run0 += l0; run1 += l1; P0[t] = run0; P1[t] = run1;
            }
            *(LAS f32x2*)(TOT + wave * 128 + 2 * lg) = (f32x2){run0, run1};
            __syncthreads();
            float off0 = 0.f, off1 = 0.f, T0 = 0.f, T1 = 0.f;
#pragma unroll
            for (int g = 0; g < 8; ++g) { const f32x2 tv = *(const LAS f32x2*)(TOT + g * 128 + 2 * lg); if (g < wave) { off0 += tv[0]; off1 += tv[1]; } T0 += tv[0]; T1 += tv[1]; }
#pragma unroll
            for (int t = 0; t < 8; ++t) {
                const int j = 8 * wave + t;
                const float pre0 = off0 + P0[t], pre1 = off1 + P1[t];
                const float l0 = P0[t] - (t ? P0[t > 0 ? t - 1 : 0] : 0.f), l1 = P1[t] - (t ? P1[t > 0 ? t - 1 : 0] : 0.f);
                const float bc0 = dir ? (T0 - pre0 + l0) : pre0, bc1 = dir ? (T1 - pre1 + l1) : pre1;
                const float e0 = __expf(-bc0), e1 = __expf(-bc1), r0 = __expf(bc0) * 0.08838834764831845f, r1 = __expf(bc1) * 0.08838834764831845f;
                const unsigned ao = offb(j, lg >> 2) + 4 * (lg & 3);
                const unsigned qw = *(const LAS unsigned*)(Qi + ao), kw = *(const LAS unsigned*)(Ki + ao);
                *(LAS unsigned*)(Qi + ao) = cvtpk(bflo(qw) * r0, bfhi(qw) * r1);
                *(LAS unsigned*)(Ki + ao) = cvtpk(bflo(kw) * e0, bfhi(kw) * e1);
            }
            if (wave == 0) *(LAS f32x2*)(EL + 2 * lg) = (f32x2){__expf(T0), __expf(T1)};
            __syncthreads();
            if (!isctx) {
                int la_ = lane; asm volatile("" : "+v"(la_));
                const int i16 = wave & 3, jh = wave >> 2, fr = la_ & 15, fq = la_ >> 4;
                f32x4 at[2] = {{0.f, 0.f, 0.f, 0.f}, {0.f, 0.f, 0.f, 0.f}};
#pragma unroll
                for (int ks = 0; ks < 4; ++ks) {
                    const bf16x8 qf = *(const LAS bf16x8*)(Qi + offb(16 * i16 + fr, 4 * ks + fq));
#pragma unroll
                    for (int jj = 0; jj < 2; ++jj) { const bf16x8 kf = *(const LAS bf16x8*)(Ki + offb(16 * (2 * jh + jj) + fr, 4 * ks + fq)); at[jj] = MFMA16(kf, qf, at[jj]); }
                }
                const int ig = 16 * i16 + fr;
#pragma unroll
                for (int jj = 0; jj < 2; ++jj) { const int j0 = 16 * (2 * jh + jj) + 4 * fq; float m[4];
#pragma unroll
                    for (int e = 0; e < 4; ++e) { const int jg = j0 + e; const bool keep = dir ? (jg >= ig) : (jg <= ig); m[e] = keep ? at[jj][e] : 0.f; }
                    v2u w; w.x = cvtpk(m[0], m[1]); w.y = cvtpk(m[2], m[3]);
                    *(LAS v2u*)(lds + OFF_P + offp(ig, j0 >> 3) + 2 * (j0 & 7)) = w; }
            }
            __syncthreads();
            if (s + 1 < 36) SCN_LOAD(s + 1);
            int lm = lane; asm volatile("" : "+v"(lm));
            const int r = lm & 31, hh = lm >> 5;
            f32x16 o[2];
#pragma unroll
            for (int i = 0; i < 16; ++i) { o[0][i] = 0.f; o[1][i] = 0.f; }
            bf16x8 vf[4];
#pragma unroll
            for (int ks = 0; ks < 4; ++ks) vf[ks] = trfrag(Vi, lm, dq, ks);
            if (!isctx) {
                bf16x8 sb[2][2];
#pragma unroll
                for (int c2 = 0; c2 < 2; ++c2)
#pragma unroll
                    for (int st = 0; st < 2; ++st) sb[c2][st] = pack_step(S[c2], st);
#pragma unroll
                for (int it = 0; it < 2; ++it) {
#pragma unroll
                    for (int c2 = 0; c2 < 2; ++c2)
#pragma unroll
                        for (int st = 0; st < 2; ++st) { const unsigned cch = 8 * ch + 4 * c2 + 2 * st;
                            const s16x4 lo = *(const LAS s16x4*)(Qi + offb(32 * it + r, cch) + 8 * hh), hi = *(const LAS s16x4*)(Qi + offb(32 * it + r, cch + 1) + 8 * hh);
                            o[it] = MFMA32(__builtin_shufflevector(lo, hi, 0, 1, 2, 3, 4, 5, 6, 7), sb[c2][st], o[it]); }
#pragma unroll
                    for (int k2 = 0; k2 < 2; ++k2) { const int ks = 2 * ch + k2; const bf16x8 pa = *(const LAS bf16x8*)(lds + OFF_P + offp(32 * it + r, 2 * ks + hh)); o[it] = MFMA32(pa, ch ? (k2 ? vf[3] : vf[2]) : (k2 ? vf[1] : vf[0]), o[it]); }
                }
            }
#pragma unroll
            for (int c2 = 0; c2 < 2; ++c2)
#pragma unroll
                for (int ks = 0; ks < 4; ++ks) S[c2] = MFMA32(trfrag(Ki, lm, 2 * ch + c2, ks), vf[ks], S[c2]);
#pragma unroll
            for (int c2 = 0; c2 < 2; ++c2)
#pragma unroll
                for (int g = 0; g < 4; ++g) { const f32x4 ev = *(const LAS f32x4*)(EL + 64 * ch + 32 * c2 + 8 * g + 4 * hh);
#pragma unroll
                    for (int e = 0; e < 4; ++e) S[c2][4 * g + e] *= ev[e]; }
            if (!isctx) {
                LAS float* X = (LAS float*)(lds + OFF_X) + wave * 1024 + lm;
#pragma unroll
                for (int i = 0; i < 16; ++i) X[64 * i] = ch ? o[0][i] : o[1][i];
            }
            __syncthreads();
            if (!isctx) {
                const LAS float* X = (const LAS float*)(lds + OFF_X) + (wave ^ 4) * 1024 + lm;
                const size_t row0 = SCN_ROW0(s);
                bf16* op = O + (row0 + 32 * ch) * VD + h * HV + dvh * 128 + 32 * dq + r;
#pragma unroll
                for (int i = 0; i < 16; ++i) { const float v = (ch ? o[1][i] : o[0][i]) + X[64 * i]; op[(size_t)((i & 3) + 8 * (i >> 2) + 4 * hh) * VD] = (bf16)f2bf(v); }
            }
            if (s + 1 < 36) SCN_STORE(BUF - bo);
            __syncthreads();
        }
#undef SCN_ROW0
#undef SCN_LOAD
#undef SCN_STORE
    }
}
#undef MFMA32
#undef MFMA16
}

#define XB_TMO      128
#define XB_XCNT(j)  (256  + 64 * (j))
#define XB_XSUB(j)  (1280 + 64 * (j))
#define XB_XGEN(j)  (2304 + 64 * (j))
#define XB_TOP      3328
#define XB_TOPGEN   3392
#define XCD_BAR_WORDS 3456
#define XB_SPIN_CAP (1u << 18)

__device__ __forceinline__ unsigned xb_ld(unsigned* p)              { return __hip_atomic_load(p, __ATOMIC_RELAXED, __HIP_MEMORY_SCOPE_AGENT); }
__device__ __forceinline__ unsigned xb_add(unsigned* p, unsigned v) { return __hip_atomic_fetch_add(p, v, __ATOMIC_RELAXED, __HIP_MEMORY_SCOPE_AGENT); }
__device__ __forceinline__ unsigned xb_xcc_id() { return (unsigned)__builtin_amdgcn_s_getreg((3 << 11) | 20) & 0xFu; }
#define XB_SPIN(cond, bar) do { unsigned _sp = 0; while (cond) { __builtin_amdgcn_s_sleep(1); \
    if ((++_sp & 255u) == 0u) { if (xb_ld(&(bar)[XB_TMO])) break; if (_sp > XB_SPIN_CAP) { atomicAdd(&(bar)[XB_TMO], 1u); break; } } } } while (0)

struct XcdBarrier {
    unsigned* bar; unsigned x;
    volatile LAS unsigned* st;
};

__device__ __forceinline__ XcdBarrier xcd_barrier_post(unsigned* bar, volatile LAS unsigned* st) {
    XcdBarrier b; b.bar = bar; b.x = xb_xcc_id(); b.st = st;
    if (threadIdx.x == 0) (void)xb_add(&bar[XB_XCNT(b.x)], 1u);
    return b;
}
__device__ __forceinline__ void xcd_barrier_complete(unsigned* bar, unsigned x, unsigned& nloc, unsigned& nx) {
    const unsigned G = gridDim.x * gridDim.y * gridDim.z;
    unsigned sum, cnt, mine, sp = 0u;
    for (;;) {
        sum = 0u; cnt = 0u; mine = 0u;
#pragma unroll
        for (unsigned j = 0; j < 16; ++j) { const unsigned c = xb_ld(&bar[XB_XCNT(j)]); sum += c; cnt += (c > 0u) ? 1u : 0u; mine = (j == x) ? c : mine; }
        if (sum == G) break;
        __builtin_amdgcn_s_sleep(1);
        if ((++sp & 255u) == 0u) { if (xb_ld(&bar[XB_TMO])) break; if (sp > XB_SPIN_CAP) { atomicAdd(&bar[XB_TMO], 1u); break; } }
    }
    nloc = mine > 0u ? mine : 1u; nx = cnt > 0u ? cnt : 1u;
}

__device__ __forceinline__ void xcd_barrier(const XcdBarrier& b) {
    asm volatile("s_waitcnt vmcnt(0)" ::: "memory");
    __syncthreads();
    if (threadIdx.x == 0) {
        unsigned* bar = b.bar;
        __builtin_amdgcn_s_waitcnt(0);
        unsigned nloc = b.st[0], nx = b.st[1];
        if (nloc == 0u) { xcd_barrier_complete(bar, b.x, nloc, nx); b.st[0] = nloc; b.st[1] = nx; }
        const unsigned old = xb_add(&bar[XB_XSUB(b.x)], 1u);
        const unsigned gen = old / nloc;
        if (old + 1u == (gen + 1u) * nloc) {
            __builtin_amdgcn_fence(__ATOMIC_RELEASE, "agent");
            asm volatile("s_waitcnt vmcnt(0)" ::: "memory");
            const unsigned og = xb_add(&bar[XB_TOP], 1u);
            const unsigned tg = og / nx;
            if (og + 1u == (tg + 1u) * nx) xb_add(&bar[XB_TOPGEN], 1u);
            else XB_SPIN(xb_ld(&bar[XB_TOPGEN]) == tg, bar);
            __builtin_amdgcn_fence(__ATOMIC_ACQUIRE, "agent");
            xb_add(&bar[XB_XGEN(b.x)], 1u);
            asm volatile("s_waitcnt vmcnt(0)" ::: "memory");
        } else {
            XB_SPIN(xb_ld(&bar[XB_XGEN(b.x)]) == gen, bar);
            __builtin_amdgcn_fence(__ATOMIC_ACQUIRE, "agent");
            asm volatile("s_waitcnt vmcnt(0)" ::: "memory");
        }
    }
    __syncthreads();
}

enum { PH_PREP = 0, PH_MOD0, PH_GIN, PH_SCAN, PH_GATE, PH_GOUT, PH_FFN0  , PH_MOD1 = PH_FFN0 + 3, PH_SCIN, PH_SCCONV, PH_SCOUT, PH_FFN1, PH_FINAL = PH_FFN1 + 3, N_PHASES };

#define IN(k) (lo <= (k) && (k) < hi)
#define SEAM(k) do { if (IN(k) && IN((k) + 1)) xcd_barrier(bar); } while (0)

__device__ __forceinline__ void ffn_block(const Params& P, LAS unsigned char* lds, const XcdBarrier& bar, int layer, int k0, int lo, int hi) {
    const int tid = threadIdx.x, lane = tid & 63, wave = __builtin_amdgcn_readfirstlane(tid >> 6);
    const int G = gridDim.x, gw = blockIdx.x * NWAVES + wave, NGW = G * NWAVES;
    unsigned char* ws = P.ws;
    const float* MODL = (const float*)(ws + WS_MOD) + (size_t)layer * MODROWS * NMOD;
    if (IN(k0)) modulate_rows<true>(P.out, NTOK, SEQ, -1, P.in[I_NFFN] + layer * D, MODL, 3, 4, (bf16*)(ws + WS_HN), gw, NGW, lane);
    SEAM(k0);
    if (IN(k0 + 1)) {
        pg8::Gemm g{(const bf16*)(ws + WS_HN), (const bf16*)(ws + WS_WUP) + (size_t)layer * FUP * D, NTOK, FUP, D};
        pg8::StaticOrder S; S.init(g.M, g.N, G, (int)blockIdx.x);
        pg8::EpiConvGate E{(bf16*)(ws + WS_ACT), FH, P.in[I_FCW] + (size_t)layer * 3 * FUP, P.in[I_FCB] + (size_t)layer * FUP, FUP};
        pg8::gemm_phase<pg8::EpiConvGate, pg8::StaticOrder, true, true>(lds, g, S, E);
    }
    SEAM(k0 + 1);
    if (IN(k0 + 2)) {
        pg8::Gemm g{(const bf16*)(ws + WS_ACT), (const bf16*)(ws + WS_WDN) + (size_t)layer * D * FH, NTOK, D, FH};
        pg8::StaticOrder S; S.init(g.M, g.N, G, (int)blockIdx.x);
        pg8::EpiResid E{P.out, P.out, MODL + 5 * D, NMOD, SEQ, D};
        pg8::gemm_phase<pg8::EpiResid, pg8::StaticOrder, true, true>(lds, g, S, E);
    }
    SEAM(k0 + 2);
}

__global__ void __launch_bounds__(NTHREADS, 2) fwd_kernel(Params P) {
    extern __shared__ __attribute__((aligned(16))) unsigned char lds_raw[];
    LAS unsigned char* lds = (LAS unsigned char*)lds_raw;
    const int tid = threadIdx.x, lane = tid & 63, wave = __builtin_amdgcn_readfirstlane(tid >> 6);
    const int G = gridDim.x, gw = blockIdx.x * NWAVES + wave, NGW = G * NWAVES, gtid = blockIdx.x * NTHREADS + tid, NT = G * NTHREADS;
    unsigned char* ws = P.ws;
    const int lo = P.ph_lo, hi = P.ph_hi;
    const float* MOD = (const float*)(ws + WS_MOD);
    bf16* HN = (bf16*)(ws + WS_HN);
    { volatile LAS unsigned* misc = (volatile LAS unsigned*)(lds + LDS_MISC); if (tid < 64) misc[tid] = 0u; }
    __syncthreads();
    const XcdBarrier bar = xcd_barrier_post((unsigned*)(ws + WS_CTL) + CW_BAR, (volatile LAS unsigned*)(lds + LDS_MISC) + 8);

    if (IN(PH_PREP)) phase_prep(P, lds, tid, wave, lane);
    SEAM(PH_PREP);
    if (IN(PH_MOD0)) {
        modulate_rows<false>(P.in[I_X], NTOK, SEQ, -1, P.in[I_NMIX], MOD, 0, 1, HN, gw, NGW, lane);
        modulate_rows<false>(P.in[I_CTX], NCTX, CTXL, 16, P.in[I_NMIX], MOD, 0, 1, HN + (size_t)NTOK * D, gw, NGW, lane);
    }
    SEAM(PH_MOD0);
    if (IN(PH_GIN)) {
        pg8::Gemm g{HN, (const bf16*)(ws + WS_WIN), MROWS, GINP, D};
        pg8::StaticOrder S; S.init(g.M, g.N, G, (int)blockIdx.x);
        pg8::EpiProj E{(bf16*)(ws + WS_PROJ), GINP, (float*)(ws + WS_ALOW), 12};
        pg8::gemm_phase<pg8::EpiProj, pg8::StaticOrder, true, true>(lds, g, S, E);
    }
    SEAM(PH_GIN);
    #ifdef SCAN_NAIVE
    if (IN(PH_SCAN)) phase_scan_naive(P, lds, tid);
#else
    if (IN(PH_SCAN)) scn::phase_scan(P, lds, tid, wave, lane);
#endif
    SEAM(PH_SCAN);
    if (IN(PH_GATE)) phase_gate(P, gw, NGW, lane);
    SEAM(PH_GATE);
    if (IN(PH_GOUT)) {
        pg8::Gemm g{HN, (const bf16*)(ws + WS_WOUT), NTOK, D, D};
        pg8::StaticOrder S; S.init(g.M, g.N, G, (int)blockIdx.x);
        pg8::EpiResid E{P.in[I_X], P.out, MOD + 2 * D, NMOD, SEQ, D};
        pg8::gemm_phase<pg8::EpiResid, pg8::StaticOrder, true, true>(lds, g, S, E);
    }
    SEAM(PH_GOUT);
    ffn_block(P, lds, bar, 0, PH_FFN0, lo, hi);
    if (IN(PH_MOD1)) modulate_rows<false>(P.out, NTOK, SEQ, -1, P.in[I_NMIX] + D, MOD + (size_t)MODROWS * NMOD, 0, 1, HN, gw, NGW, lane);
    SEAM(PH_MOD1);
    if (IN(PH_SCIN)) {
        pg8::Gemm g{HN, (const bf16*)(ws + WS_SCIN), NTOK, 3 * D, D};
        pg8::StaticOrder S; S.init(g.M, g.N, G, (int)blockIdx.x);
        pg8::EpiBf16 E{(bf16*)(ws + WS_BCV), 3 * D};
        pg8::gemm_phase<pg8::EpiBf16, pg8::StaticOrder, true, true>(lds, g, S, E);
    }
    SEAM(PH_SCIN);
    if (IN(PH_SCCONV)) phase_scconv(P, gtid, NT);
    SEAM(PH_SCCONV);
    if (IN(PH_SCOUT)) {
        pg8::Gemm g{HN, (const bf16*)(ws + WS_SCOUT), NTOK, D, D};
        pg8::StaticOrder S; S.init(g.M, g.N, G, (int)blockIdx.x);
        pg8::EpiResid E{P.out, P.out, MOD + (size_t)MODROWS * NMOD + 2 * D, NMOD, SEQ, D};
        pg8::gemm_phase<pg8::EpiResid, pg8::StaticOrder, true, true>(lds, g, S, E);
    }
    SEAM(PH_SCOUT);
    ffn_block(P, lds, bar, 1, PH_FFN1, lo, hi);
    if (IN(PH_FINAL)) final_norm_rows(P.out, P.in[I_FINAL], gw, NGW, lane);
}
#undef IN
#undef SEAM

#ifndef MK_ONE_LAUNCH
#define MK_ONE_LAUNCH 1
#endif
extern "C" void kernel_launch(void* const* d_in, const int* in_sizes, int n_in, void* d_out, int out_size, void* d_ws, size_t ws_size, hipStream_t stream) {
    static int grid = 0;
    if (grid == 0) {
        if (n_in != N_IN || out_size != NTOK * D || ws_size < WS_END) { fprintf(stderr, "kernel_launch: unexpected shapes (n_in %d out %d ws %zu)\n", n_in, out_size, ws_size); grid = -1; return; }
        int dev = 0, cus = 0, per_cu = 0;
        if (hipGetDevice(&dev) != hipSuccess || hipDeviceGetAttribute(&cus, hipDeviceAttributeMultiprocessorCount, dev) != hipSuccess) { grid = -1; return; }
        if (hipFuncSetAttribute((const void*)fwd_kernel, hipFuncAttributeMaxDynamicSharedMemorySize, LDS_BYTES) != hipSuccess) { fprintf(stderr, "kernel_launch: hipFuncSetAttribute failed\n"); grid = -1; return; }
        if (hipOccupancyMaxActiveBlocksPerMultiprocessor(&per_cu, (const void*)fwd_kernel, NTHREADS, LDS_BYTES) != hipSuccess || per_cu < 1) { fprintf(stderr, "kernel_launch: occupancy query says %d\n", per_cu); per_cu = 1; }
        (void)hipGetLastError();
        grid = cus;
    }
    if (grid < 0) return;
    (void)hipMemsetAsync((char*)d_ws + WS_CTL, 0, CTL_ZERO_BYTES, stream);
    Params p{};
    for (int i = 0; i < N_IN; ++i) p.in[i] = (const float*)d_in[i];
    p.out = (float*)d_out; p.ws = (unsigned char*)d_ws;
#if MK_ONE_LAUNCH
    p.ph_lo = 0; p.ph_hi = N_PHASES;
    void* args[] = {&p};
    hipError_t e = hipLaunchCooperativeKernel((const void*)fwd_kernel, dim3(grid), dim3(NTHREADS), args, LDS_BYTES, stream);
    if (e != hipSuccess) fprintf(stderr, "cooperative launch failed: %s (grid %d)\n", hipGetErrorString(e), grid);
#else
    for (int ph = 0; ph < N_PHASES; ++ph) { p.ph_lo = ph; p.ph_hi = ph + 1; hipLaunchKernelGGL(fwd_kernel, dim3(grid), dim3(NTHREADS), LDS_BYTES, stream, p); }
#endif
}
```
